# Optimizing an MI355X kernel written in HIP

```python
import jax, jax.numpy as jnp
from jax import lax
import numpy as np

D_MODEL = 2048
BATCH = 4
SEQ = 2048
DEPTH = 1
DEC_BATCH = 128
DEC_SEQ = 1
PAST_LEN = 16384
PAGE_SIZE = 128

D_A = D_MODEL // 2
HEAD = 64
H_A = D_A // HEAD
LORA_W = 64
LORA_A = 64
D_B = D_MODEL // 2
CONV_K = 31
PLE_DIM = 256
SHIFT_W = 3 * D_A + LORA_W + LORA_A
N_IN = SHIFT_W + D_A + 2 * D_B + D_B + 2 * D_MODEL
RMS_EPS = 1e-6
LN_EPS = 1e-5
GN_EPS = 64e-5

kernel_name = 'rwkv7_conformer_gated_hybrid_step'


def _rmsnorm(x, g):
    xf = x.astype(jnp.float32)
    xf = xf * lax.rsqrt(jnp.mean(xf * xf, axis=-1, keepdims=True) + RMS_EPS)
    return (xf * g.astype(jnp.float32)).astype(x.dtype)


def _wkv7_scan(S0, r, w, k, v, a, b):
    def step(S, inp):
        r_t, w_t, k_t, v_t, a_t, b_t = inp
        sa = jnp.einsum('bhij,bhj->bhi', S, a_t)
        S = S * w_t[:, :, None, :] + sa[..., None] * b_t[:, :, None, :] + v_t[..., None] * k_t[:, :, None, :]
        return S, jnp.einsum('bhij,bhj->bhi', S, r_t)
    seq = tuple(jnp.swapaxes(t.astype(jnp.float32), 0, 1) for t in (r, w, k, v, a, b))
    S, ys = lax.scan(step, S0.astype(jnp.float32), seq)
    return S, jnp.swapaxes(ys, 0, 1)


def _layer(x, p, shift_prev, wkv_prev, conv_prev, norm_g, w_in, shift_mu, w0, w_lora_b, a0, a_lora_b,
           k_k, k_a, r_k, lnx_g, lnx_b, w_proj_a, conv_w, conv_b, cln_g, cln_b, w_proj_b, w_out,
           w_ple, w_ple_gate):
    f32 = jnp.float32
    Bn, T, _ = x.shape
    dt = x.dtype
    xn = _rmsnorm(x, norm_g)
    proj = jnp.einsum('btd,dn->btn', xn, w_in)
    o1 = SHIFT_W
    o2 = o1 + D_A
    o3 = o2 + 2 * D_B
    o4 = o3 + D_B
    p_shift = proj[..., :o1]
    gate_a = proj[..., o1:o2]
    glu_in = proj[..., o2:o3]
    gate_b = proj[..., o3:o4]
    merge = proj[..., o4:]

    prev = jnp.concatenate([shift_prev[:, None].astype(dt), p_shift[:, :-1]], axis=1)
    xs = p_shift + shift_mu * (prev - p_shift)
    new_shift = p_shift[:, -1]
    r = xs[..., :D_A]
    k = xs[..., D_A:2 * D_A]
    v = xs[..., 2 * D_A:3 * D_A]
    xw = xs[..., 3 * D_A:3 * D_A + LORA_W]
    xa = xs[..., 3 * D_A + LORA_W:]
    w_log = -jax.nn.softplus(-(w0 + jnp.tanh(xw) @ w_lora_b).astype(f32)) - 0.5
    decay = jnp.exp(-jnp.exp(w_log))
    a = jax.nn.sigmoid((a0 + xa @ a_lora_b).astype(f32))
    hd = lambda t: t.reshape(Bn, T, H_A, HEAD)
    kk = hd(k.astype(f32) * k_k)
    kk = kk / jnp.maximum(jnp.sqrt(jnp.sum(kk * kk, axis=-1, keepdims=True)), 1e-12)
    kf = hd(k.astype(f32) * (1.0 + (a - 1.0) * k_a))
    rf = hd(r.astype(f32))
    vf = hd(v.astype(f32))
    S, o = _wkv7_scan(wkv_prev, rf, hd(decay), kf, vf, -kk, kk * hd(a))
    mu = jnp.mean(o, axis=-1, keepdims=True)
    var = jnp.mean(jnp.square(o - mu), axis=-1, keepdims=True)
    o = ((o - mu) * lax.rsqrt(var + GN_EPS)).reshape(Bn, T, D_A) * lnx_g + lnx_b
    bonus = jnp.sum(rf * kf * r_k, axis=-1, keepdims=True) * vf
    o = o + bonus.reshape(Bn, T, D_A)
    y_a = jnp.einsum('btc,cd->btd', (o * jax.nn.silu(gate_a.astype(f32))).astype(dt), w_proj_a)

    u = glu_in[..., :D_B] * jax.nn.sigmoid(glu_in[..., D_B:])
    ucat = jnp.concatenate([conv_prev.astype(dt), u], axis=1)
    c = lax.conv_general_dilated(ucat, conv_w[:, None, :].astype(dt), (1,), 'VALID',
                                 dimension_numbers=('NWC', 'WIO', 'NWC'),
                                 feature_group_count=D_B) + conv_b
    new_conv = ucat[:, -(CONV_K - 1):]
    cf = c.astype(f32)
    cm = jnp.mean(cf, axis=-1, keepdims=True)
    cv = jnp.mean(jnp.square(cf - cm), axis=-1, keepdims=True)
    cf = (cf - cm) * lax.rsqrt(cv + LN_EPS) * cln_g + cln_b
    cb = jax.nn.silu(cf) * jax.nn.silu(gate_b.astype(f32))
    y_b = jnp.einsum('btc,cd->btd', cb.astype(dt), w_proj_b)

    ga = merge[..., :D_MODEL]
    gb = merge[..., D_MODEL:]
    m = jax.nn.sigmoid(ga) * y_a + jax.nn.sigmoid(gb) * y_b
    h = x + jnp.einsum('btd,de->bte', m, w_out)
    h = h + jax.nn.sigmoid(jnp.einsum('btd,de->bte', h, w_ple_gate)) * jnp.einsum('btp,pd->btd', p, w_ple)
    return h, new_shift, S.astype(wkv_prev.dtype), new_conv


def setup_inputs(seed: int = 0) -> dict:
    key = jax.random.key(seed)
    ks = jax.random.split(key, 32)
    nrm = lambda k, s, sc: jax.random.normal(k, s, jnp.float32) * sc
    L = DEPTH
    return {
        'x_prompt': nrm(ks[0], (BATCH, SEQ, D_MODEL), 1.0),
        'x_sample': nrm(ks[1], (DEC_BATCH, DEC_SEQ, D_MODEL), 1.0),
        'state_shift': nrm(ks[2], (L, DEC_BATCH, SHIFT_W), 1.0),
        'state_wkv': nrm(ks[3], (L, DEC_BATCH, H_A, HEAD, HEAD), 0.3),
        'state_conv': nrm(ks[4], (L, DEC_BATCH, CONV_K - 1, D_B), 0.5),
        'p_prompt': nrm(ks[5], (L, BATCH, SEQ, PLE_DIM), 1.0),
        'p_sample': nrm(ks[6], (L, DEC_BATCH, DEC_SEQ, PLE_DIM), 1.0),
        'norm_g': 1.0 + nrm(ks[7], (L, D_MODEL), 0.01),
        'w_in': nrm(ks[8], (L, D_MODEL, N_IN), D_MODEL ** -0.5),
        'shift_mu': jax.random.uniform(ks[9], (L, SHIFT_W), jnp.float32),
        'w0': jax.random.uniform(ks[10], (L, D_A), jnp.float32, -6.0, 0.0),
        'w_lora_b': nrm(ks[11], (L, LORA_W, D_A), 0.1 * LORA_W ** -0.5),
        'a0': nrm(ks[12], (L, D_A), 0.1),
        'a_lora_b': nrm(ks[13], (L, LORA_A, D_A), 0.1 * LORA_A ** -0.5),
        'k_k': 0.85 + nrm(ks[14], (L, D_A), 0.02),
        'k_a': 1.0 + nrm(ks[15], (L, D_A), 0.02),
        'r_k': nrm(ks[16], (L, H_A, HEAD), 0.1),
        'lnx_g': 1.0 + nrm(ks[17], (L, D_A), 0.01),
        'lnx_b': nrm(ks[18], (L, D_A), 0.01),
        'w_proj_a': nrm(ks[19], (L, D_A, D_MODEL), D_A ** -0.5),
        'conv_w': nrm(ks[20], (L, CONV_K, D_B), CONV_K ** -0.5),
        'conv_b': nrm(ks[21], (L, D_B), 0.01),
        'cln_g': 1.0 + nrm(ks[22], (L, D_B), 0.01),
        'cln_b': nrm(ks[23], (L, D_B), 0.01),
        'w_proj_b': nrm(ks[24], (L, D_B, D_MODEL), D_B ** -0.5),
        'w_out': nrm(ks[25], (L, D_MODEL, D_MODEL), D_MODEL ** -0.5),
        'w_ple': nrm(ks[26], (L, PLE_DIM, D_MODEL), PLE_DIM ** -0.5),
        'w_ple_gate': nrm(ks[27], (L, D_MODEL, D_MODEL), D_MODEL ** -0.5),
        'final_g': 1.0 + nrm(ks[28], (D_MODEL,), 0.01),
    }


def reference(x_prompt, x_sample, state_shift, state_wkv, state_conv, p_prompt, p_sample,
              norm_g, w_in, shift_mu, w0, w_lora_b, a0, a_lora_b, k_k, k_a, r_k, lnx_g, lnx_b,
              w_proj_a, conv_w, conv_b, cln_g, cln_b, w_proj_b, w_out, w_ple, w_ple_gate, final_g):
    Bp = x_prompt.shape[0]
    hp, hs = x_prompt, x_sample
    ps_shift, ps_wkv, ps_conv = [], [], []
    ss_shift, ss_wkv, ss_conv = [], [], []
    for i in range(DEPTH):
        lw = (norm_g[i], w_in[i], shift_mu[i], w0[i], w_lora_b[i], a0[i], a_lora_b[i], k_k[i], k_a[i],
              r_k[i], lnx_g[i], lnx_b[i], w_proj_a[i], conv_w[i], conv_b[i], cln_g[i], cln_b[i],
              w_proj_b[i], w_out[i], w_ple[i], w_ple_gate[i])
        hp, sh, wk, cv = _layer(hp, p_prompt[i],
                                jnp.zeros((Bp, SHIFT_W), x_prompt.dtype),
                                jnp.zeros((Bp, H_A, HEAD, HEAD), jnp.float32),
                                jnp.zeros((Bp, CONV_K - 1, D_B), x_prompt.dtype), *lw)
        ps_shift.append(sh)
        ps_wkv.append(wk)
        ps_conv.append(cv)
        hs, sh, wk, cv = _layer(hs, p_sample[i], state_shift[i], state_wkv[i], state_conv[i], *lw)
        ss_shift.append(sh)
        ss_wkv.append(wk)
        ss_conv.append(cv)
    y_prompt = _rmsnorm(hp, final_g)
    y_sample = _rmsnorm(hs, final_g)
    return (y_prompt, y_sample, jnp.stack(ps_shift), jnp.stack(ps_wkv), jnp.stack(ps_conv),
            jnp.stack(ss_shift), jnp.stack(ss_wkv), jnp.stack(ss_conv))
```

```cpp
#include <hip/hip_runtime.h>
#include <cstdio>
#include <cstdint>
namespace pg8 {
#define PG8_LAS __attribute__((address_space(3)))
typedef unsigned short bf16_t;
typedef short bf16x8 __attribute__((ext_vector_type(8)));
typedef float f32x4 __attribute__((ext_vector_type(4)));
typedef unsigned u32x4 __attribute__((ext_vector_type(4)));
constexpr int BM = 256, BK = 64, HALF = 128, HTB = HALF * BK * 2  , STAGE_BYTES = 8 * HTB, NXCD = 8, WGM = 8;

__host__ __device__ __forceinline__ int lds_byte(int r, int c) { const int st = (r >> 4) * 2 + (c >> 5), rr = r & 15, cc = c & 31, ob = rr * 64 + cc * 2; return st * 1024 + (ob ^ (((ob >> 9) & 1) << 5)); }
__host__ __device__ __forceinline__ void stage_rc(int b, int& R, int& C) { const int st = b / 1024, sb = b % 1024, swz = sb ^ (((sb >> 9) & 1) << 5); R = (st >> 1) * 16 + swz / 64; C = (st & 1) * 32 + (swz % 64) / 2; }
__host__ __device__ __forceinline__ int perm32(int rho) { const int n = rho >> 4, i = rho & 15; return 8 * (i >> 2) + 4 * n + (i & 3); }

struct Unit { int pm, pn; };
struct Gemm { const bf16_t* A; const bf16_t* Bt; int M, N, K; };

struct StaticOrder {
    int nM, nN, nwg, G, c;
    __host__ __device__ void init(int M, int N, int G_, int c_) { nM = M / BM; nN = N / BM; nwg = nM * nN; G = G_; c = c_; }
    __host__ __device__ bool next(int i, Unit& u) const {
        const long L = (long)i * G + c; if (L >= nwg) return false;
        int wgid = (int)L; { const int q = nwg / NXCD, r = nwg % NXCD, xcd = wgid % NXCD, off = wgid / NXCD; wgid = (xcd < r ? xcd * (q + 1) : r * (q + 1) + (xcd - r) * q) + off; }
        const int nig = WGM * nN, gid = wgid / nig, fm = gid * WGM, gsz = (nM - fm) < WGM ? (nM - fm) : WGM;
        u.pm = fm + ((wgid % nig) % gsz); u.pn = (wgid % nig) / gsz; return true;
    }
    __device__ __forceinline__ void a_ready(const Unit&) const {}
    __device__ __forceinline__ void done(const Unit&) const {}
};


__device__ __forceinline__ unsigned cvt_pk_bf16(float lo, float hi) { unsigned r; asm volatile("v_cvt_pk_bf16_f32 %0, %1, %2" : "=v"(r) : "v"(lo), "v"(hi)); return r; }
__device__ __forceinline__ float bflo(unsigned u) { return __uint_as_float(u << 16); }
__device__ __forceinline__ float bfhi(unsigned u) { return __uint_as_float(u & 0xffff0000u); }
__device__ __forceinline__ float sigm(float x) { return __builtin_amdgcn_rcpf(1.0f + __expf(-x)); }
constexpr int E_MV = 8320;

struct EpiProj {
    static constexpr bool PERM = true, AFTER_DRAIN = false, HAS_MID = false;
    bf16_t *PS, *GA, *GLU, *GB, *MG;
    __device__ __forceinline__ void operator()(const f32x4 (&acc)[2][2][4][2], const Unit& u, int wr, int wc, int fr, int fq) const {
        bf16_t* base; int ldc, ct; const int pn = u.pn;
        if (pn < 13) { base = PS; ldc = 3328; ct = pn; } else if (pn < 17) { base = GA; ldc = 1024; ct = pn - 13; } else if (pn < 25) { base = GLU; ldc = 2048; ct = pn - 17; }
        else if (pn < 29) { base = GB; ldc = 1024; ct = pn - 25; } else { base = MG; ldc = 4096; ct = pn - 29; }
        int row0 = u.pm * BM + wr * 64 + fr; const int col0 = ct * BM + wc * 32 + 8 * fq; const bool glu = pn >= 17 && pn < 25;
        asm volatile("" : "+v"(row0));
#pragma unroll
        for (int ai = 0; ai < 2; ++ai)
#pragma unroll
            for (int m = 0; m < 4; ++m) {
                if (glu) { bf16_t* rowp = GLU + (size_t)(row0 + ai * HALF + m * 16) * 1024 + ct * HALF + wc * 32 + 8 * fq;
                    const f32x4 v0 = acc[ai][0][m][0], v1 = acc[ai][0][m][1], g0 = acc[ai][1][m][0], g1 = acc[ai][1][m][1];
                    u32x4 w; w.x = cvt_pk_bf16(v0[0] * sigm(g0[0]), v0[1] * sigm(g0[1])); w.y = cvt_pk_bf16(v0[2] * sigm(g0[2]), v0[3] * sigm(g0[3]));
                    w.z = cvt_pk_bf16(v1[0] * sigm(g1[0]), v1[1] * sigm(g1[1])); w.w = cvt_pk_bf16(v1[2] * sigm(g1[2]), v1[3] * sigm(g1[3]));
                    *(u32x4*)rowp = w;
                } else { bf16_t* rowp = base + (size_t)(row0 + ai * HALF + m * 16) * ldc + col0;
#pragma unroll
                    for (int bj = 0; bj < 2; ++bj) { const f32x4 v0 = acc[ai][bj][m][0], v1 = acc[ai][bj][m][1];
                        u32x4 w; w.x = cvt_pk_bf16(v0[0], v0[1]); w.y = cvt_pk_bf16(v0[2], v0[3]); w.z = cvt_pk_bf16(v1[0], v1[1]); w.w = cvt_pk_bf16(v1[2], v1[3]);
                        *(u32x4*)(rowp + bj * HALF) = w; } }
                asm volatile("" ::: "memory"); }
    }
};
struct EpiStoreBf16 {
    static constexpr bool PERM = true, AFTER_DRAIN = false, HAS_MID = false;
    bf16_t* O; int ldc;
    __device__ __forceinline__ void operator()(const f32x4 (&acc)[2][2][4][2], const Unit& u, int wr, int wc, int fr, int fq) const {
        const int row0 = u.pm * BM + wr * 64 + fr, col0 = u.pn * BM + wc * 32 + 8 * fq;
#pragma unroll
        for (int ai = 0; ai < 2; ++ai)
#pragma unroll
            for (int m = 0; m < 4; ++m) { bf16_t* rowp = O + (size_t)(row0 + ai * HALF + m * 16) * ldc + col0;
#pragma unroll
                for (int bj = 0; bj < 2; ++bj) { const f32x4 v0 = acc[ai][bj][m][0], v1 = acc[ai][bj][m][1];
                    u32x4 w; w.x = cvt_pk_bf16(v0[0], v0[1]); w.y = cvt_pk_bf16(v0[2], v0[3]); w.z = cvt_pk_bf16(v1[0], v1[1]); w.w = cvt_pk_bf16(v1[2], v1[3]);
                    *(u32x4*)(rowp + bj * HALF) = w; } }
    }
};
struct EpiGate {
    static constexpr bool PERM = true, AFTER_DRAIN = false, HAS_MID = true;
    const bf16_t* MG; bf16_t* Mb;
    __device__ __forceinline__ void mid(f32x4 (&acc)[2][2][4][2], const Unit& u, int wr, int wc, int fr, int fq) const {
        int row0 = u.pm * BM + wr * 64 + fr, col0 = u.pn * BM + wc * 32 + 8 * fq;
        asm volatile("" : "+v"(row0), "+v"(col0));
#pragma unroll
        for (int ai = 0; ai < 2; ++ai)
#pragma unroll
            for (int m = 0; m < 4; ++m) { const size_t row = (size_t)(row0 + ai * HALF + m * 16);
#pragma unroll
                for (int bj = 0; bj < 2; ++bj) { const int col = col0 + bj * HALF;
                    const u32x4 ga = *(const u32x4*)(MG + row * 4096 + col), gb = *(const u32x4*)(MG + row * 4096 + 2048 + col);
#define EG_F(a_, b_) (sigm(a_) * (1.0f + __expf(-(b_))))
                    acc[ai][bj][m][0][0] *= EG_F(bflo(ga.x), bflo(gb.x)); acc[ai][bj][m][0][1] *= EG_F(bfhi(ga.x), bfhi(gb.x)); acc[ai][bj][m][0][2] *= EG_F(bflo(ga.y), bflo(gb.y)); acc[ai][bj][m][0][3] *= EG_F(bfhi(ga.y), bfhi(gb.y));
                    acc[ai][bj][m][1][0] *= EG_F(bflo(ga.z), bflo(gb.z)); acc[ai][bj][m][1][1] *= EG_F(bfhi(ga.z), bfhi(gb.z)); acc[ai][bj][m][1][2] *= EG_F(bflo(ga.w), bflo(gb.w)); acc[ai][bj][m][1][3] *= EG_F(bfhi(ga.w), bfhi(gb.w));
#undef EG_F
                }
                asm volatile("" ::: "memory"); }
    }
    __device__ __forceinline__ void operator()(const f32x4 (&acc)[2][2][4][2], const Unit& u, int wr, int wc, int fr, int fq) const {
        const int row0 = u.pm * BM + wr * 64 + fr, col0 = u.pn * BM + wc * 32 + 8 * fq;
#pragma unroll
        for (int ai = 0; ai < 2; ++ai)
#pragma unroll
            for (int m = 0; m < 4; ++m) { const size_t row = (size_t)(row0 + ai * HALF + m * 16);
#pragma unroll
                for (int bj = 0; bj < 2; ++bj) { const int col = col0 + bj * HALF; const u32x4 g = *(const u32x4*)(MG + row * 4096 + 2048 + col);
                    f32x4 v0 = acc[ai][bj][m][0], v1 = acc[ai][bj][m][1];
                    v0[0] *= sigm(bflo(g.x)); v0[1] *= sigm(bfhi(g.x)); v0[2] *= sigm(bflo(g.y)); v0[3] *= sigm(bfhi(g.y));
                    v1[0] *= sigm(bflo(g.z)); v1[1] *= sigm(bfhi(g.z)); v1[2] *= sigm(bflo(g.w)); v1[3] *= sigm(bfhi(g.w));
                    u32x4 w; w.x = cvt_pk_bf16(v0[0], v0[1]); w.y = cvt_pk_bf16(v0[2], v0[3]); w.z = cvt_pk_bf16(v1[0], v1[1]); w.w = cvt_pk_bf16(v1[2], v1[3]);
                    *(u32x4*)(Mb + row * 2048 + col) = w; }
                asm volatile("" ::: "memory"); }
    }
};
struct EpiRes {
    static constexpr bool PERM = true, AFTER_DRAIN = false, HAS_MID = false;
    const float* xp; const float* xs; bf16_t* HB;
    __device__ __forceinline__ void operator()(const f32x4 (&acc)[2][2][4][2], const Unit& u, int wr, int wc, int fr, int fq) const {
        const int row0 = u.pm * BM + wr * 64 + fr, col0 = u.pn * BM + wc * 32 + 8 * fq;
#pragma unroll
        for (int ai = 0; ai < 2; ++ai)
#pragma unroll
            for (int m = 0; m < 4; ++m) { const int r = row0 + ai * HALF + m * 16; const size_t row = (size_t)r; const bool valid = r < E_MV;
                const float* xr = r < 8192 ? xp + row * 2048 : xs + (size_t)(r - 8192) * 2048;
#pragma unroll
                for (int bj = 0; bj < 2; ++bj) { const int col = col0 + bj * HALF;
                    f32x4 v0 = acc[ai][bj][m][0], v1 = acc[ai][bj][m][1];
                    if (valid) { v0 += *(const f32x4*)(xr + col); v1 += *(const f32x4*)(xr + col + 4); }
                    u32x4 w; w.x = cvt_pk_bf16(v0[0], v0[1]); w.y = cvt_pk_bf16(v0[2], v0[3]); w.z = cvt_pk_bf16(v1[0], v1[1]); w.w = cvt_pk_bf16(v1[2], v1[3]);
                    *(u32x4*)(HB + row * 2048 + col) = w; }
                asm volatile("" ::: "memory"); }
    }
};
struct EpiPle {
    static constexpr bool PERM = true, AFTER_DRAIN = false, HAS_MID = false;
    const bf16_t* HB; const bf16_t* E; bf16_t* H2B;
    __device__ __forceinline__ void operator()(const f32x4 (&acc)[2][2][4][2], const Unit& u, int wr, int wc, int fr, int fq) const {
        const int row0 = u.pm * BM + wr * 64 + fr, col0 = u.pn * BM + wc * 32 + 8 * fq;
#pragma unroll
        for (int ai = 0; ai < 2; ++ai)
#pragma unroll
            for (int m = 0; m < 4; ++m) { const int r = row0 + ai * HALF + m * 16; const size_t row = (size_t)r;
                if (r < E_MV) {
#pragma unroll
                for (int bj = 0; bj < 2; ++bj) { const int col = col0 + bj * HALF; const u32x4 e = *(const u32x4*)(E + row * 2048 + col), h = *(const u32x4*)(HB + row * 2048 + col);
                    const f32x4 v0 = acc[ai][bj][m][0], v1 = acc[ai][bj][m][1];
                    f32x4 h0, h1;
                    h0[0] = bflo(h.x) + sigm(v0[0]) * bflo(e.x); h0[1] = bfhi(h.x) + sigm(v0[1]) * bfhi(e.x); h0[2] = bflo(h.y) + sigm(v0[2]) * bflo(e.y); h0[3] = bfhi(h.y) + sigm(v0[3]) * bfhi(e.y);
                    h1[0] = bflo(h.z) + sigm(v1[0]) * bflo(e.z); h1[1] = bfhi(h.z) + sigm(v1[1]) * bfhi(e.z); h1[2] = bflo(h.w) + sigm(v1[2]) * bflo(e.w); h1[3] = bfhi(h.w) + sigm(v1[3]) * bfhi(e.w);
                    u32x4 w; w.x = cvt_pk_bf16(h0[0], h0[1]); w.y = cvt_pk_bf16(h0[2], h0[3]); w.z = cvt_pk_bf16(h1[0], h1[1]); w.w = cvt_pk_bf16(h1[2], h1[3]);
                    *(u32x4*)(H2B + row * 2048 + col) = w; } }
                asm volatile("" ::: "memory"); }
    }
};

template <class Epi, class Sched, bool ALIGN_EPI = false, bool SP2 = false>
__device__ __forceinline__ void gemm_phase(PG8_LAS unsigned char* lds, const Gemm g, const Sched& S, const Epi& E) {
    int tid_ = threadIdx.x; asm volatile("" : "+v"(tid_));
    const int tid = tid_, wid = __builtin_amdgcn_readfirstlane(tid >> 6), lane = tid & 63, wr = wid >> 2, wc = wid & 3, fr = lane & 15, fq = lane >> 4;
    const int K = g.K, nt = K / BK;
    unsigned voffA[2], voffB[2];
#pragma unroll
    for (int i = 0; i < 2; ++i) { int R, C; stage_rc(tid * 16 + i * 8192, R, C); const int Rb = Epi::PERM ? ((R & ~31) + perm32(R & 31)) : R;
        voffA[i] = (unsigned)(R * K + C) * 2u; voffB[i] = (unsigned)(Rb * K + C) * 2u; }
    const size_t kstep = (size_t)(BK * 2);
    const size_t hstep = (size_t)HALF * K * 2;
    const size_t tstep = 2 * hstep;
    const unsigned ldsw = (unsigned)wid * 1024u;
    const int aoff = lds_byte(wr * 64 + fr, fq * 8), boff = lds_byte(wc * 32 + fr, fq * 8);
#define PG8_SA(b, h) (((b) * 2 + (h)) * HTB)
#define PG8_SB(b, h) ((4 + (b) * 2 + (h)) * HTB)
#define PG8_STAGE(bufoff, gbase, voff) do { _Pragma("unroll") for (int _i = 0; _i < 2; ++_i) \
        __builtin_amdgcn_global_load_lds((const unsigned*)((const char*)(gbase) + (voff)[_i]), (PG8_LAS unsigned*)(lds + (bufoff) + ldsw + _i * 8192), 16, 0, 0); } while (0)
#define PG8_LDA(dst, b, h) do { _Pragma("unroll") for (int m = 0; m < 4; ++m) _Pragma("unroll") for (int k = 0; k < 2; ++k) dst[m][k] = *(const PG8_LAS bf16x8*)(lds + PG8_SA(b, h) + aoff + m * 2048 + k * 1024); } while (0)
#define PG8_LDB(dst, b, h) do { _Pragma("unroll") for (int n = 0; n < 2; ++n) _Pragma("unroll") for (int k = 0; k < 2; ++k) dst[n][k] = *(const PG8_LAS bf16x8*)(lds + PG8_SB(b, h) + boff + n * 2048 + k * 1024); } while (0)
#define PG8_MMA(ai, bj, At, Bt) do { __builtin_amdgcn_s_setprio(1); _Pragma("unroll") for (int m = 0; m < 4; ++m) _Pragma("unroll") for (int n = 0; n < 2; ++n) _Pragma("unroll") for (int k = 0; k < 2; ++k) \
        acc[ai][bj][m][n] = __builtin_amdgcn_mfma_f32_16x16x32_bf16(Bt[n][k], At[m][k], acc[ai][bj][m][n], 0, 0, 0); __builtin_amdgcn_s_setprio(0); } while (0)
#define PG8_WAIT_V(n) asm volatile("s_waitcnt vmcnt(" #n ")" ::: "memory")
#define PG8_WAIT_L(n) asm volatile("s_waitcnt lgkmcnt(" #n ")" ::: "memory")
#define PG8_BAR __builtin_amdgcn_s_barrier()
#define PG8_SCHED __builtin_amdgcn_sched_barrier(0)
    Unit cur, nxt; int ui = 0;
    if (!S.next(0, cur)) return;
    f32x4 acc[2][2][4][2];
#pragma unroll
    for (int a = 0; a < 2; ++a)
#pragma unroll
        for (int b = 0; b < 2; ++b)
#pragma unroll
            for (int m = 0; m < 4; ++m)
#pragma unroll
                for (int n = 0; n < 2; ++n) acc[a][b][m][n] = (f32x4){0.f, 0.f, 0.f, 0.f};
    bf16x8 At[4][2], B0[2][2], B1[2][2];
    const char* cA = (const char*)g.A + (size_t)cur.pm * tstep; const char* cB = (const char*)g.Bt + (size_t)cur.pn * tstep;
    S.a_ready(cur);
    if constexpr (SP2) {
        PG8_STAGE(PG8_SB(0, 0), cB, voffB); PG8_STAGE(PG8_SB(0, 1), cB + hstep, voffB); PG8_STAGE(PG8_SA(0, 0), cA, voffA); PG8_STAGE(PG8_SA(0, 1), cA + hstep, voffA);
        if (wr == 1) PG8_BAR;
        PG8_WAIT_V(2); PG8_BAR;
        PG8_STAGE(PG8_SB(1, 0), cB + kstep, voffB); PG8_STAGE(PG8_SA(1, 0), cA + kstep, voffA); PG8_STAGE(PG8_SB(1, 1), cB + hstep + kstep, voffB);
        PG8_WAIT_V(6); PG8_BAR;
    } else {
        PG8_STAGE(PG8_SB(0, 0), cB, voffB); PG8_STAGE(PG8_SA(0, 0), cA, voffA); PG8_STAGE(PG8_SB(0, 1), cB + hstep, voffB); PG8_STAGE(PG8_SA(0, 1), cA + hstep, voffA);
        if (wr == 1) PG8_BAR;
        PG8_WAIT_V(4); PG8_BAR;
        PG8_STAGE(PG8_SB(1, 0), cB + kstep, voffB); PG8_STAGE(PG8_SA(1, 0), cA + kstep, voffA); PG8_STAGE(PG8_SB(1, 1), cB + hstep + kstep, voffB);
        PG8_WAIT_V(6); PG8_BAR;
    }
    for (;;) {
        const bool has_next = S.next(ui + 1, nxt);
        const char* nA = has_next ? (const char*)g.A + (size_t)nxt.pm * tstep : cA; const char* nB = has_next ? (const char*)g.Bt + (size_t)nxt.pn * tstep : cB;
        for (int t = 0; t < nt; t += 2) {
            if constexpr (Epi::HAS_MID) { if (t == nt / 2) { int t2_ = threadIdx.x; asm volatile("" : "+v"(t2_)); const int l2_ = t2_ & 63; E.mid(acc, cur, wr, wc, l2_ & 15, l2_ >> 4); } }
            const bool last = (t == nt - 2);
            const char* a1 = cA + (size_t)(t + 1) * kstep;
            const char* a2 = last ? nA : cA + (size_t)(t + 2) * kstep; const char* b2 = last ? nB : cB + (size_t)(t + 2) * kstep;
            const char* a3 = a2 + kstep; const char* b3 = b2 + kstep;
            if (last && has_next) S.a_ready(nxt);
            if constexpr (SP2) {
            PG8_LDB(B0, 0, 0); PG8_LDB(B1, 0, 1); PG8_SCHED; PG8_LDA(At, 0, 0); PG8_STAGE(PG8_SA(1, 1), a1 + hstep, voffA);
            PG8_WAIT_V(8); PG8_WAIT_L(0); PG8_BAR; PG8_MMA(0, 0, At, B0); PG8_MMA(0, 1, At, B1); PG8_BAR; PG8_SCHED;
            PG8_LDA(At, 0, 1); PG8_STAGE(PG8_SB(0, 0), b2, voffB); PG8_STAGE(PG8_SB(0, 1), b2 + hstep, voffB); PG8_STAGE(PG8_SA(0, 0), a2, voffA);
            PG8_WAIT_V(8); PG8_WAIT_L(0); PG8_BAR; PG8_MMA(1, 0, At, B0); PG8_MMA(1, 1, At, B1); PG8_BAR; PG8_SCHED;
            PG8_LDB(B0, 1, 0); PG8_LDB(B1, 1, 1); PG8_SCHED; PG8_LDA(At, 1, 0); PG8_STAGE(PG8_SA(0, 1), a2 + hstep, voffA);
            PG8_WAIT_V(8); PG8_WAIT_L(0); PG8_BAR; PG8_MMA(0, 0, At, B0); PG8_MMA(0, 1, At, B1); PG8_BAR; PG8_SCHED;
            PG8_LDA(At, 1, 1); PG8_STAGE(PG8_SB(1, 0), b3, voffB); PG8_STAGE(PG8_SB(1, 1), b3 + hstep, voffB); PG8_STAGE(PG8_SA(1, 0), a3, voffA);
            PG8_WAIT_V(8); PG8_WAIT_L(0); PG8_BAR; PG8_MMA(1, 0, At, B0); PG8_MMA(1, 1, At, B1); PG8_BAR; PG8_SCHED;
            } else {
            PG8_LDB(B0, 0, 0); PG8_SCHED; PG8_LDA(At, 0, 0); PG8_STAGE(PG8_SA(1, 1), a1 + hstep, voffA);
            PG8_WAIT_L(8); PG8_BAR; PG8_WAIT_L(0); PG8_MMA(0, 0, At, B0); PG8_BAR; PG8_SCHED;
            PG8_LDB(B1, 0, 1); PG8_STAGE(PG8_SB(0, 0), b2, voffB);
            PG8_BAR; PG8_WAIT_L(0); PG8_MMA(0, 1, At, B1); PG8_BAR;
            PG8_LDA(At, 0, 1); PG8_STAGE(PG8_SA(0, 0), a2, voffA);
            PG8_BAR; PG8_WAIT_L(0); PG8_MMA(1, 0, At, B0); PG8_BAR; PG8_SCHED;
            PG8_STAGE(PG8_SB(0, 1), b2 + hstep, voffB);
            PG8_WAIT_V(6); PG8_BAR; PG8_MMA(1, 1, At, B1); PG8_BAR;
            PG8_LDB(B0, 1, 0); PG8_SCHED; PG8_LDA(At, 1, 0); PG8_STAGE(PG8_SA(0, 1), a2 + hstep, voffA);
            PG8_WAIT_L(8); PG8_BAR; PG8_WAIT_L(0); PG8_MMA(0, 0, At, B0); PG8_BAR; PG8_SCHED;
            PG8_LDB(B1, 1, 1); PG8_STAGE(PG8_SB(1, 0), b3, voffB);
            PG8_BAR; PG8_WAIT_L(0); PG8_MMA(0, 1, At, B1); PG8_BAR;
            PG8_LDA(At, 1, 1); PG8_STAGE(PG8_SA(1, 0), a3, voffA);
            PG8_BAR; PG8_WAIT_L(0); PG8_MMA(1, 0, At, B0); PG8_BAR; PG8_SCHED;
            PG8_STAGE(PG8_SB(1, 1), b3 + hstep, voffB);
            PG8_WAIT_V(6); PG8_BAR; PG8_MMA(1, 1, At, B1); PG8_BAR;
            }
        }
        if constexpr (ALIGN_EPI) { if (wr == 0) PG8_BAR; }
        if constexpr (!Epi::AFTER_DRAIN) { { int t2_ = threadIdx.x; asm volatile("" : "+v"(t2_)); const int l2_ = t2_ & 63; E(acc, cur, wr, wc, l2_ & 15, l2_ >> 4); }     S.done(cur); }
        if (!has_next) break;
#pragma unroll
        for (int a = 0; a < 2; ++a)
#pragma unroll
            for (int b = 0; b < 2; ++b)
#pragma unroll
                for (int m = 0; m < 4; ++m)
#pragma unroll
                    for (int n = 0; n < 2; ++n) acc[a][b][m][n] = (f32x4){0.f, 0.f, 0.f, 0.f};
        cur = nxt; cA = nA; cB = nB; ++ui;
        if constexpr (ALIGN_EPI) { if (wr == 1) PG8_BAR; }
    }
    PG8_WAIT_V(0);
    if constexpr (!ALIGN_EPI) { if (wr == 0) PG8_BAR; }
    PG8_BAR;
    if constexpr (Epi::AFTER_DRAIN) { E.fused(acc, cur, wr, wc, fr, fq, lds, wid, lane); S.done(cur); }
#undef PG8_SA
#undef PG8_SB
#undef PG8_STAGE
#undef PG8_LDA
#undef PG8_LDB
#undef PG8_MMA
#undef PG8_WAIT_V
#undef PG8_WAIT_L
#undef PG8_BAR
#undef PG8_SCHED
}
}

constexpr int NWAVES = 8, NTHR = NWAVES * 64;
#ifndef MK_N_LAUNCHES
#define MK_N_LAUNCHES 1
#endif
#ifndef PROBE_DUP
#define PROBE_DUP -1
#endif
#ifndef USE_CHUNKED
#define USE_CHUNKED 1
#endif
#ifndef PROBE_P3MODE
#define PROBE_P3MODE 0
#endif
constexpr int PER_PHASE = 10;
constexpr int N_LAUNCHES = MK_N_LAUNCHES;

constexpr int DM = 2048, SEQ = 2048, NB = 4, MP = NB * SEQ  , MS = 128, MV = MP + MS  , MPAD = 8448  ;
constexpr int DA = 1024, NH = 16, HD = 64, SHW = 3200, PSW = 3328, N1 = 11520, NIN = 11392, CK = 31, PLE = 256;
constexpr float RMS_EPS = 1e-6f, LN_EPS = 1e-5f, GN_EPS = 64e-5f;
static_assert(MV == pg8::E_MV, "row count");
constexpr size_t O_YP = 0, O_YS = (size_t)MP * DM, O_SHP = O_YS + (size_t)MS * DM, O_WKP = O_SHP + (size_t)NB * SHW, O_CVP = O_WKP + (size_t)NB * NH * HD * HD,
                 O_SHS = O_CVP + (size_t)NB * 30 * DA, O_WKS = O_SHS + (size_t)MS * SHW, O_CVS = O_WKS + (size_t)MS * NH * HD * HD, O_END = O_CVS + (size_t)MS * 30 * DA;
static_assert(O_END == 30167552, "output size");

constexpr size_t MiB = 1u << 20;
constexpr size_t WS_CTL = 0, CTL_ZERO_BYTES = 1 * MiB;
constexpr size_t WS_WAT = 1 * MiB, WS_WBT = 5 * MiB, WS_WOT = 9 * MiB, WS_WGT = 17 * MiB, WS_WPT = 25 * MiB, WS_WLT = 26 * MiB, WS_ALT = 26 * MiB + 128 * 1024, WS_PB = 27 * MiB;
constexpr size_t WS_GA = 32 * MiB, WS_GLU = 49 * MiB, WS_GB = 82 * MiB, WS_MG = 99 * MiB;
constexpr size_t WS_Y = 165 * MiB;
constexpr size_t WS_PS = WS_Y, WS_OA = WS_Y, WS_CB = WS_Y + 1024 * 2, WS_HB = WS_Y;
constexpr int OAS = 2048;
constexpr size_t WS_X = 219 * MiB;
constexpr size_t WS_WTIN = WS_X, WS_XN = WS_X + 45 * MiB;
constexpr size_t SCAN_N = (size_t)65 * 2048 * 64;
constexpr size_t WS_SW = WS_X, WS_SA = WS_SW + SCAN_N * 4, WS_SB = WS_SA + SCAN_N * 2, WS_SK = WS_SB + SCAN_N * 2, WS_SWR = WS_SK + SCAN_N * 2, WS_SV = WS_SWR + SCAN_N * 2,
                 WS_SBR = WS_SV + SCAN_N * 2, WS_SKR = WS_SBR + 65 * 2048 * 4, WS_SBS = WS_SKR + 65 * 2048 * 4, WS_SEND = WS_SBS + 65 * 2048 * 4;
constexpr size_t WS_T = WS_X, WS_MB = WS_X + 66 * MiB, WS_H2B = WS_X + 33 * MiB;
constexpr size_t WS_E = WS_GLU;
constexpr size_t WS_END = 335 * MiB;
static_assert(WS_PB + (size_t)MPAD * PLE * 2 <= WS_GA && WS_GA + (size_t)MPAD * 1024 * 2 <= WS_GLU && WS_GLU + (size_t)MPAD * 2048 * 2 <= WS_GB && WS_GB + (size_t)MPAD * 1024 * 2 <= WS_MG &&
              WS_MG + (size_t)MPAD * 4096 * 2 <= WS_Y && WS_PS + (size_t)MPAD * PSW * 2 <= WS_X && WS_OA + (size_t)MPAD * OAS * 2 <= WS_X &&
              WS_WTIN + (size_t)N1 * DM * 2 <= WS_XN && WS_XN + (size_t)MPAD * DM * 2 <= WS_END && WS_SEND <= WS_END && WS_T + (size_t)MPAD * DM * 4 <= WS_MB && WS_MB + (size_t)MPAD * DM * 2 <= WS_END &&
              WS_HB + (size_t)MPAD * DM * 2 <= WS_X, "d_ws map");
constexpr int CW_ROWSQ = 65536;
constexpr int FUSE_NORM = 1;
constexpr int LATE_IN_P1 = 0;
constexpr int CW_BAR = 4096;

constexpr int RING_BYTES = 131072, LDSCTL_OFF = 143360  , MISC_OFF = LDSCTL_OFF + 320, LDS_BYTES = 147456;

#define GAS __attribute__((address_space(1)))
#define LAS __attribute__((address_space(3)))
typedef unsigned short bf16;
typedef unsigned v4u __attribute__((ext_vector_type(4)));
typedef unsigned v2u __attribute__((ext_vector_type(2)));
typedef float f32x4 __attribute__((ext_vector_type(4)));
typedef float f32x2 __attribute__((ext_vector_type(2)));
typedef short bf16x8 __attribute__((ext_vector_type(8)));
typedef GAS unsigned gu32;
#define RLX_AGENT __ATOMIC_RELAXED, __HIP_MEMORY_SCOPE_AGENT
#define LDS_WAIT() asm volatile("s_waitcnt lgkmcnt(0)" ::: "memory")
#define VM_WAIT() asm volatile("s_waitcnt vmcnt(0)" ::: "memory")
#define LDS_BAR() asm volatile("s_waitcnt lgkmcnt(0)\n\ts_barrier" ::: "memory")
typedef __bf16 bf16x2_hw __attribute__((ext_vector_type(2)));
__device__ __forceinline__ unsigned pk2(float lo, float hi) { const f32x2 v = {lo, hi}; const bf16x2_hw b = __builtin_convertvector(v, bf16x2_hw); return __builtin_bit_cast(unsigned, b); }
__device__ __forceinline__ unsigned f2bf(float f) { return pk2(f, f) & 0xffffu; }
__device__ __forceinline__ float bflo(unsigned u) { return __uint_as_float(u << 16); }
__device__ __forceinline__ float bfhi(unsigned u) { return __uint_as_float(u & 0xffff0000u); }
__device__ __forceinline__ float bf1(bf16 b) { return __uint_as_float((unsigned)b << 16); }
__device__ __forceinline__ float sigm(float x) { return __builtin_amdgcn_rcpf(1.0f + __expf(-x)); }
__device__ __forceinline__ float silu2(float x, float y) { return (x * y) * __builtin_amdgcn_rcpf((1.0f + __expf(-x)) * (1.0f + __expf(-y))); }
__device__ __forceinline__ float tanh_fast(float x) { return 1.0f - 2.0f * __builtin_amdgcn_rcpf(1.0f + __expf(2.0f * x)); }
template <int CTRL> __device__ __forceinline__ float dpp_f(float x) { return __builtin_bit_cast(float, __builtin_amdgcn_update_dpp(0, __builtin_bit_cast(int, x), CTRL, 0xf, 0xf, true)); }
__device__ __forceinline__ float reduce16(float x) { x += dpp_f<0xB1>(x); x += dpp_f<0x4E>(x); x += dpp_f<0x124>(x); x += dpp_f<0x128>(x); return x; }
__device__ __forceinline__ float wave_sum(float v) {
    const int i = __builtin_bit_cast(int, reduce16(v));
    return (__builtin_bit_cast(float, __builtin_amdgcn_readlane(i, 0)) + __builtin_bit_cast(float, __builtin_amdgcn_readlane(i, 16))) +
           (__builtin_bit_cast(float, __builtin_amdgcn_readlane(i, 32)) + __builtin_bit_cast(float, __builtin_amdgcn_readlane(i, 48)));
}

__device__ __forceinline__ float row_sum4(float v) {
    const int i = __builtin_bit_cast(int, v);
    return (__builtin_bit_cast(float, __builtin_amdgcn_readlane(i, 0)) + __builtin_bit_cast(float, __builtin_amdgcn_readlane(i, 16))) +
           (__builtin_bit_cast(float, __builtin_amdgcn_readlane(i, 32)) + __builtin_bit_cast(float, __builtin_amdgcn_readlane(i, 48)));
}

#define XB_TMO      128
#define XB_XCNT(j)  (256  + 64 * (j))
#define XB_XSUB(j)  (1280 + 64 * (j))
#define XB_XGEN(j)  (2304 + 64 * (j))
#define XB_TOP      3328
#define XB_TOPGEN   3392
#define XCD_BAR_WORDS 3456
#define XB_SPIN_CAP (1u << 18)
__device__ __forceinline__ unsigned xb_ld(unsigned* p)              { return __hip_atomic_load(p, __ATOMIC_RELAXED, __HIP_MEMORY_SCOPE_AGENT); }
__device__ __forceinline__ unsigned xb_add(unsigned* p, unsigned v) { return __hip_atomic_fetch_add(p, v, __ATOMIC_RELAXED, __HIP_MEMORY_SCOPE_AGENT); }
__device__ __forceinline__ unsigned xb_xcc_id() { return (unsigned)__builtin_amdgcn_s_getreg((3 << 11) | 20) & 0xFu; }
#define XB_SPIN(cond, bar) do { unsigned _sp = 0; while (cond) { __builtin_amdgcn_s_sleep(1); \
    if ((++_sp & 255u) == 0u) { if (xb_ld(&(bar)[XB_TMO])) break; if (_sp > XB_SPIN_CAP) { atomicAdd(&(bar)[XB_TMO], 1u); break; } } } } while (0)
struct XcdBarrier { unsigned* bar; unsigned x; volatile LAS unsigned* st; };
__device__ __forceinline__ XcdBarrier xcd_barrier_post(unsigned* bar, volatile LAS unsigned* st) {
    XcdBarrier b; b.bar = bar; b.x = xb_xcc_id(); b.st = st;
    if (threadIdx.x == 0) (void)xb_add(&bar[XB_XCNT(b.x)], 1u);
    return b;
}
__device__ __forceinline__ void xcd_barrier_complete(unsigned* bar, unsigned x, unsigned& nloc, unsigned& nx) {
    const unsigned G = gridDim.x * gridDim.y * gridDim.z;
    unsigned sum, cnt, mine, sp = 0u;
    for (;;) {
        sum = 0u; cnt = 0u; mine = 0u;
#pragma unroll
        for (unsigned j = 0; j < 16; ++j) { const unsigned c = xb_ld(&bar[XB_XCNT(j)]); sum += c; cnt += (c > 0u) ? 1u : 0u; mine = (j == x) ? c : mine; }
        if (sum == G) break;
        __builtin_amdgcn_s_sleep(1);
        if ((++sp & 255u) == 0u) { if (xb_ld(&bar[XB_TMO])) break; if (sp > XB_SPIN_CAP) { atomicAdd(&bar[XB_TMO], 1u); break; } }
    }
    nloc = mine > 0u ? mine : 1u; nx = cnt > 0u ? cnt : 1u;
}
__device__ __forceinline__ void xcd_barrier(const XcdBarrier& b) {
    asm volatile("s_waitcnt vmcnt(0)" ::: "memory");
    __syncthreads();
    if (threadIdx.x == 0) {
        unsigned* bar = b.bar;
        __builtin_amdgcn_s_waitcnt(0);
        unsigned nloc = b.st[0], nx = b.st[1];
        if (nloc == 0u) { xcd_barrier_complete(bar, b.x, nloc, nx); b.st[0] = nloc; b.st[1] = nx; }
        const unsigned old = xb_add(&bar[XB_XSUB(b.x)], 1u);
        const unsigned gen = old / nloc;
        if (old + 1u == (gen + 1u) * nloc) {
            __builtin_amdgcn_fence(__ATOMIC_RELEASE, "agent");
            asm volatile("s_waitcnt vmcnt(0)" ::: "memory");
            const unsigned og = xb_add(&bar[XB_TOP], 1u);
            const unsigned tg = og / nx;
            if (og + 1u == (tg + 1u) * nx) xb_add(&bar[XB_TOPGEN], 1u);
            else XB_SPIN(xb_ld(&bar[XB_TOPGEN]) == tg, bar);
            __builtin_amdgcn_fence(__ATOMIC_ACQUIRE, "agent");
            xb_add(&bar[XB_XGEN(b.x)], 1u);
            asm volatile("s_waitcnt vmcnt(0)" ::: "memory");
        } else {
            XB_SPIN(xb_ld(&bar[XB_XGEN(b.x)]) == gen, bar);
            __builtin_amdgcn_fence(__ATOMIC_ACQUIRE, "agent");
            asm volatile("s_waitcnt vmcnt(0)" ::: "memory");
        }
    }
    __syncthreads();
}

struct Args { const float* in[29]; float* out; unsigned char* ws; int ph_lo, ph_hi, li, pad; };
struct PArgs { LAS unsigned char* lds; };
__device__ __forceinline__ const float* argp(const PArgs& a, int i) {
    const v2u p = *(const LAS v2u*)(a.lds + LDSCTL_OFF + 8 * i);
    const unsigned long long q = ((unsigned long long)(unsigned)__builtin_amdgcn_readfirstlane((int)p.y) << 32) | (unsigned)__builtin_amdgcn_readfirstlane((int)p.x);
    return (const float*)(const GAS float*)q;
}
#define A_IN(i) argp(a, (i))
#define A_OUT ((float*)argp(a, 29))
#define A_WS ((unsigned char*)argp(a, 30))
__device__ __forceinline__ int opaque_tid() { int t = threadIdx.x; asm volatile("" : "+v"(t)); return t; }
enum { I_XP = 0, I_XS, I_SSHIFT, I_SWKV, I_SCONV, I_PP, I_PS, I_NORMG, I_WIN, I_MU, I_W0, I_WLB, I_A0, I_ALB, I_KK, I_KA, I_RK, I_LNXG, I_LNXB, I_WPA, I_CONVW, I_CONVB, I_CLNG, I_CLNB, I_WPB, I_WOUT,
       I_WPLE, I_WPG, I_FING };

__device__ __forceinline__ void p0_transpose_item(const float* W, int K, int N, bf16* WT, int gap_at, LAS float* scr, int item, int lane, int ldk = 0, int koff = 0) {
    if (ldk == 0) ldk = K;
    const int nblk = N / 32, kb = item / nblk, nb = item % nblk, k0 = 64 * kb, n0 = 32 * nb, row_off = (n0 >= gap_at) ? 128 : 0;
    int n0d = n0; if (gap_at == SHW && n0 >= 4224 && n0 < 4224 + 2048) { const int j_ = n0 - 4224, ch_ = j_ & 1023, gt_ = j_ >> 10; n0d = 4224 + (ch_ >> 7) * 256 + gt_ * 128 + (ch_ & 127); }
#pragma unroll
    for (int i = 0; i < 8; ++i) { const int kk = 8 * i + (lane >> 3), n4 = (lane & 7) * 4; const f32x4 v = *(const f32x4*)(W + (size_t)(k0 + kk) * N + n0 + n4);
        LAS float* d = scr + kk * 33 + n4; d[0] = v.x; d[1] = v.y; d[2] = v.z; d[3] = v.w; }
    LDS_WAIT(); asm volatile("" ::: "memory");
    const int c = lane & 7;
#pragma unroll
    for (int j = 0; j < 4; ++j) { const int n = (lane >> 3) + 8 * j; const LAS float* s = scr + (8 * c) * 33 + n;
        v4u o; o.x = pk2(s[0 * 33], s[1 * 33]); o.y = pk2(s[2 * 33], s[3 * 33]); o.z = pk2(s[4 * 33], s[5 * 33]); o.w = pk2(s[6 * 33], s[7 * 33]);
        *(GAS v4u*)(WT + (size_t)(row_off + n0d + n) * ldk + koff + k0 + 8 * c) = o; }
    LDS_WAIT(); asm volatile("" ::: "memory");
}
__device__ __forceinline__ void p0_item_load(f32x4 (&v)[8], const float* W, int N, int item, int lane) {
    const int nblk = N / 32, kb = item / nblk, nb = item % nblk, k0 = 64 * kb, n0 = 32 * nb;
#pragma unroll
    for (int i = 0; i < 8; ++i) { const int kk = 8 * i + (lane >> 3), n4 = (lane & 7) * 4; v[i] = *(const f32x4*)(W + (size_t)(k0 + kk) * N + n0 + n4); }
}
__device__ __forceinline__ void p0_item_store(const f32x4 (&v)[8], int K, int N, bf16* WT, int gap_at, LAS float* scr, int item, int lane) {
    const int nblk = N / 32, kb = item / nblk, nb = item % nblk, k0 = 64 * kb, n0 = 32 * nb, row_off = (n0 >= gap_at) ? 128 : 0;
    int n0d = n0; if (gap_at == SHW && n0 >= 4224 && n0 < 4224 + 2048) { const int j_ = n0 - 4224, ch_ = j_ & 1023, gt_ = j_ >> 10; n0d = 4224 + (ch_ >> 7) * 256 + gt_ * 128 + (ch_ & 127); }
#pragma unroll
    for (int i = 0; i < 8; ++i) { const int kk = 8 * i + (lane >> 3), n4 = (lane & 7) * 4; LAS float* d = scr + kk * 33 + n4; d[0] = v[i].x; d[1] = v[i].y; d[2] = v[i].z; d[3] = v[i].w; }
    LDS_WAIT(); asm volatile("" ::: "memory");
    const int c = lane & 7;
#pragma unroll
    for (int j = 0; j < 4; ++j) { const int n = (lane >> 3) + 8 * j; const LAS float* s_ = scr + (8 * c) * 33 + n;
        v4u o; o.x = pk2(s_[0 * 33], s_[1 * 33]); o.y = pk2(s_[2 * 33], s_[3 * 33]); o.z = pk2(s_[4 * 33], s_[5 * 33]); o.w = pk2(s_[6 * 33], s_[7 * 33]);
        *(GAS v4u*)(WT + (size_t)(row_off + n0d + n) * K + k0 + 8 * c) = o; }
    LDS_WAIT(); asm volatile("" ::: "memory");
}
__device__ __forceinline__ void p0_prologue(const PArgs& a, LAS unsigned char* lds, int lane, int wave, int vcu, int G) {
    unsigned char* ws = A_WS;
    LAS float* scr = (LAS float*)(lds + wave * 16384);
    const int gw = vcu * NWAVES + wave, NGW = G * NWAVES;
    constexpr int NOGAP = 1 << 30;
    constexpr int I_IN = (DM / 64) * (NIN / 32), I_A = (DA / 64) * (DM / 32), I_O = (DM / 64) * (DM / 32), I_P = (PLE / 64) * (DM / 32), I_L = (64 / 64) * (DA / 32);
    constexpr int NITEMS = I_IN + 2 * I_L;
    {
        const float* Win = A_IN(I_WIN); bf16* WtIn = (bf16*)(ws + WS_WTIN);
        f32x4 va[8], vb[8]; int it = gw;
        if (it < I_IN) p0_item_load(va, Win, NIN, it, lane);
        for (; it < I_IN; it += 2 * NGW) {
            if (it + NGW < I_IN) p0_item_load(vb, Win, NIN, it + NGW, lane);
            p0_item_store(va, DM, NIN, WtIn, SHW, scr, it, lane);
            if (it + NGW < I_IN) { if (it + 2 * NGW < I_IN) p0_item_load(va, Win, NIN, it + 2 * NGW, lane); p0_item_store(vb, DM, NIN, WtIn, SHW, scr, it + NGW, lane); }
        }
    }
    for (int it = I_IN + gw; it < NITEMS; it += NGW) {
        int r = it;
        if (r < I_IN) { p0_transpose_item(A_IN(I_WIN), DM, NIN, (bf16*)(ws + WS_WTIN), SHW, scr, r, lane); continue; } r -= I_IN;
        if (r < I_L) { p0_transpose_item(A_IN(I_WLB), 64, DA, (bf16*)(ws + WS_WLT), NOGAP, scr, r, lane); continue; } r -= I_L;
        p0_transpose_item(A_IN(I_ALB), 64, DA, (bf16*)(ws + WS_ALT), NOGAP, scr, r, lane);
    }
    { GAS v4u* z = (GAS v4u*)(ws + WS_WTIN + (size_t)SHW * DM * 2); for (int i = gw * 64 + lane; i < 128 * DM * 2 / 16; i += NGW * 64) z[i] = (v4u){0u, 0u, 0u, 0u}; }
    const float* xp = A_IN(I_XP); const float* xs = A_IN(I_XS); const float* ng = A_IN(I_NORMG);
    bf16* XN = (bf16*)(ws + WS_XN);
    for (int m = gw; m < MPAD; m += NGW) {
        GAS v2u* o8 = (GAS v2u*)(XN + (size_t)m * DM) + lane;
        if (m >= MV) {
#pragma unroll
            for (int j = 0; j < 8; ++j) o8[64 * j] = (v2u){0u, 0u};
            continue; }
        const GAS f32x4* xr = (const GAS f32x4*)(m < MP ? xp + (size_t)m * DM : xs + (size_t)(m - MP) * DM) + lane;
        f32x4 v[8]; float s = 0.f;
#pragma unroll
        for (int j = 0; j < 8; ++j) { v[j] = xr[64 * j]; s += (v[j].x * v[j].x + v[j].y * v[j].y) + (v[j].z * v[j].z + v[j].w * v[j].w); }
        const float rs = 1.0f / sqrtf(wave_sum(s) * (1.0f / DM) + RMS_EPS);
#pragma unroll
        for (int j = 0; j < 8; ++j) { const f32x4 g = ((const GAS f32x4*)ng)[lane + 64 * j]; const f32x4 y = v[j] * rs * g; o8[64 * j] = (v2u){pk2(y.x, y.y), pk2(y.z, y.w)}; }
    }
    const float* pp = A_IN(I_PP); const float* ps = A_IN(I_PS);
    bf16* PB = (bf16*)(ws + WS_PB);
    for (int m = gw; m < MPAD; m += NGW) {
        GAS v2u* o8 = (GAS v2u*)(PB + (size_t)m * PLE) + lane;
        if (m >= MV) { *o8 = (v2u){0u, 0u}; continue; }
        const f32x4 v = ((const GAS f32x4*)(m < MP ? pp + (size_t)m * PLE : ps + (size_t)(m - MP) * PLE))[lane];
        *o8 = (v2u){pk2(v.x, v.y), pk2(v.z, v.w)};
    }
}

__device__ __forceinline__ void late_weights(const PArgs& a, LAS unsigned char* lds, int lane, int wave, int grp, int gwi, int ngw) {
    unsigned char* ws = A_WS;
    LAS float* scr = (LAS float*)(lds + wave * 16384);
    constexpr int NOGAP = 1 << 30;
    constexpr int I_A = (DA / 64) * (DM / 32), I_O = (DM / 64) * (DM / 32), I_P = (PLE / 64) * (DM / 32);
    if (grp == 0) {
        for (int r = gwi; r < 2 * I_A; r += ngw) {
            if (r < I_A) p0_transpose_item(A_IN(I_WPA), DA, DM, (bf16*)(ws + WS_WAT), NOGAP, scr, r, lane, 2 * DA, 0);
            else p0_transpose_item(A_IN(I_WPB), DA, DM, (bf16*)(ws + WS_WAT), NOGAP, scr, r - I_A, lane, 2 * DA, DA); }
    } else {
        for (int r = gwi; r < 2 * I_O + I_P; r += ngw) {
            if (r < I_O) p0_transpose_item(A_IN(I_WOUT), DM, DM, (bf16*)(ws + WS_WOT), NOGAP, scr, r, lane);
            else if (r < 2 * I_O) p0_transpose_item(A_IN(I_WPG), DM, DM, (bf16*)(ws + WS_WGT), NOGAP, scr, r - I_O, lane);
            else p0_transpose_item(A_IN(I_WPLE), PLE, DM, (bf16*)(ws + WS_WPT), NOGAP, scr, r - 2 * I_O, lane); }
    }
}

struct PrepC { float mur, muk, muv, w0, a0, kk, ka, rk; };
__device__ __forceinline__ void prep_phase(const PArgs& a, LAS unsigned char* lds, int tid, int lane, int wave) {
    unsigned char* ws = A_WS;
    const bf16* PS = (const bf16*)(ws + WS_PS); const bf16* WlT = (const bf16*)(ws + WS_WLT); const bf16* AlT = (const bf16*)(ws + WS_ALT);
    const float* mu = A_IN(I_MU); const float* sst = A_IN(I_SSHIFT);
    float* SW = (float*)(ws + WS_SW); bf16* SA = (bf16*)(ws + WS_SA); bf16* SB = (bf16*)(ws + WS_SB); bf16* SK = (bf16*)(ws + WS_SK); bf16* SWR = (bf16*)(ws + WS_SWR); bf16* SV = (bf16*)(ws + WS_SV);
    float* SBR = (float*)(ws + WS_SBR); float* SKR = (float*)(ws + WS_SKR); float* SBS = (float*)(ws + WS_SBS);
    LAS bf16* Aw = (LAS bf16*)lds; LAS bf16* Aa = Aw + 16 * 64;
    const int fr = lane & 15, fq = lane >> 4;
    for (int it = blockIdx.x; it < MP / 16; it += gridDim.x) {
        const int m0 = it * 16;
        {
            const int tok = tid >> 5, j = (tid & 31) * 4, m = m0 + tok, col = 3072 + j;
            const v2u pc = *(const v2u*)(PS + (size_t)m * PSW + col);
            f32x4 p = {bflo(pc.x), bfhi(pc.x), bflo(pc.y), bfhi(pc.y)}, q = {0.f, 0.f, 0.f, 0.f};
            if (m < MP) { if ((m & (SEQ - 1)) != 0) { const v2u qc = *(const v2u*)(PS + (size_t)(m - 1) * PSW + col); q = (f32x4){bflo(qc.x), bfhi(qc.x), bflo(qc.y), bfhi(qc.y)}; } }
            else q = *(const f32x4*)(sst + (size_t)(m - MP) * SHW + col);
            const f32x4 mu4 = *(const f32x4*)(mu + col);
            f32x4 x = p + mu4 * (q - p);
            if (j < 64) { x.x = tanh_fast(x.x); x.y = tanh_fast(x.y); x.z = tanh_fast(x.z); x.w = tanh_fast(x.w); }
            LAS bf16* dst = (j < 64) ? (Aw + tok * 64 + j) : (Aa + tok * 64 + (j - 64));
            *(LAS v2u*)dst = (v2u){pk2(x.x, x.y), pk2(x.z, x.w)};
        }
        if (m0 >= MP) { for (int idx = tid; idx < 16 * (SHW / 4); idx += NTHR) { const int tok = idx / (SHW / 4), c4 = (idx % (SHW / 4)) * 4; const v2u v = *(const v2u*)(PS + (size_t)(m0 + tok) * PSW + c4);
                *(f32x4*)(A_OUT + O_SHS + (size_t)(m0 - MP + tok) * SHW + c4) = (f32x4){bflo(v.x), bfhi(v.x), bflo(v.y), bfhi(v.y)}; } }
        else if ((m0 & (SEQ - 1)) == SEQ - 16) { const int b = m0 / SEQ; for (int idx = tid; idx < SHW / 4; idx += NTHR) { const int c4 = idx * 4; const v2u v = *(const v2u*)(PS + (size_t)(m0 + 15) * PSW + c4);
                *(f32x4*)(A_OUT + O_SHP + (size_t)b * SHW + c4) = (f32x4){bflo(v.x), bfhi(v.x), bflo(v.y), bfhi(v.y)}; } }
        LDS_WAIT(); __syncthreads();
        bf16x8 aw[2], aa[2];
#pragma unroll
        for (int kb = 0; kb < 2; ++kb) { aw[kb] = *(const LAS bf16x8*)(Aw + fr * 64 + kb * 32 + 8 * fq); aa[kb] = *(const LAS bf16x8*)(Aa + fr * 64 + kb * 32 + 8 * fq); }
        const int mq = m0 + 4 * fq;
#pragma unroll 1
        for (int hh = 0; hh < 2; ++hh) {
            const int h = wave * 2 + hh;
            f32x4 lw[4], la[4]; PrepC C[4];
#pragma unroll
            for (int blk = 0; blk < 4; ++blk) {
                const int ch = h * 64 + blk * 16 + fr;
                const bf16x8 bw0 = *(const bf16x8*)(WlT + (size_t)ch * 64 + 8 * fq), bw1 = *(const bf16x8*)(WlT + (size_t)ch * 64 + 32 + 8 * fq);
                const bf16x8 ba0 = *(const bf16x8*)(AlT + (size_t)ch * 64 + 8 * fq), ba1 = *(const bf16x8*)(AlT + (size_t)ch * 64 + 32 + 8 * fq);
                f32x4 z = {0.f, 0.f, 0.f, 0.f};
                lw[blk] = __builtin_amdgcn_mfma_f32_16x16x32_bf16(aw[0], bw0, z, 0, 0, 0); lw[blk] = __builtin_amdgcn_mfma_f32_16x16x32_bf16(aw[1], bw1, lw[blk], 0, 0, 0);
                la[blk] = __builtin_amdgcn_mfma_f32_16x16x32_bf16(aa[0], ba0, z, 0, 0, 0); la[blk] = __builtin_amdgcn_mfma_f32_16x16x32_bf16(aa[1], ba1, la[blk], 0, 0, 0);
                C[blk].mur = mu[ch]; C[blk].muk = mu[1024 + ch]; C[blk].muv = mu[2048 + ch]; C[blk].w0 = A_IN(I_W0)[ch]; C[blk].a0 = A_IN(I_A0)[ch];
                C[blk].kk = A_IN(I_KK)[ch]; C[blk].ka = A_IN(I_KA)[ch]; C[blk].rk = A_IN(I_RK)[ch];
            }
            float cR[4][4], cK[4][4], cV[4][4], pR[4], pK[4], pV[4];
#pragma unroll
            for (int reg = 0; reg < 4; ++reg)
#pragma unroll
                for (int blk = 0; blk < 4; ++blk) { const bf16* pr = PS + (size_t)(mq + reg) * PSW + h * 64 + blk * 16 + fr; cR[reg][blk] = bf1(pr[0]); cK[reg][blk] = bf1(pr[1024]); cV[reg][blk] = bf1(pr[2048]); }
            {   const bool has_prev = mq < MP && (mq & (SEQ - 1)) != 0;
#pragma unroll
                for (int blk = 0; blk < 4; ++blk) { const bf16* pr = PS + (size_t)(has_prev ? mq - 1 : mq) * PSW + h * 64 + blk * 16 + fr;
                    const float r0 = bf1(pr[0]), k0 = bf1(pr[1024]), v0 = bf1(pr[2048]); pR[blk] = has_prev ? r0 : 0.f; pK[blk] = has_prev ? k0 : 0.f; pV[blk] = has_prev ? v0 : 0.f; } }
#pragma unroll
            for (int reg = 0; reg < 4; ++reg) {
                const int m = mq + reg;
                float r_[4], kf_[4], v_[4], kkr_[4], al_[4], dc_[4];
                float n2 = 0.f, sbr = 0.f, skr = 0.f, sbs = 0.f;
                if (m >= MP) {
#pragma unroll
                    for (int blk = 0; blk < 4; ++blk) { const float* st = sst + (size_t)(m - MP) * SHW + h * 64 + blk * 16 + fr; pR[blk] = st[0]; pK[blk] = st[1024]; pV[blk] = st[2048]; }
                }
#pragma unroll
                for (int blk = 0; blk < 4; ++blk) {
                    const float cr = cR[reg][blk], ck = cK[reg][blk], cv = cV[reg][blk];
                    const float r = cr + C[blk].mur * (pR[blk] - cr), k = ck + C[blk].muk * (pK[blk] - ck), v = cv + C[blk].muv * (pV[blk] - cv);
                    pR[blk] = cr; pK[blk] = ck; pV[blk] = cv;
                    const float sg = sigm(C[blk].w0 + lw[blk][reg]);
                    const float dc = __expf(-0.6065306597126334f * sg);
                    const float al = sigm(C[blk].a0 + la[blk][reg]);
                    const float kkr = k * C[blk].kk, kf = k * (1.0f + (al - 1.0f) * C[blk].ka);
                    n2 += kkr * kkr; sbr += kkr * al * r; skr += kf * r; sbs += r * kf * C[blk].rk;
                    r_[blk] = r; kf_[blk] = kf; v_[blk] = v; kkr_[blk] = kkr; al_[blk] = al; dc_[blk] = dc;
                }
                n2 = reduce16(n2); sbr = reduce16(sbr); skr = reduce16(skr); sbs = reduce16(sbs);
                const float inv = 1.0f / fmaxf(sqrtf(n2), 1e-12f);
                const size_t tix = (size_t)((m / SEQ) * NH + h) * SEQ + (m & (SEQ - 1));
                LAS float* oW = (LAS float*)(lds + 8192 + wave * 14336); LAS bf16* oB = (LAS bf16*)(oW + 1024);
#pragma unroll
                for (int blk = 0; blk < 4; ++blk) {
                    const int o = (4 * fq + reg) * 64 + blk * 16 + fr; const float kk = kkr_[blk] * inv;
                    oW[o] = dc_[blk]; oB[o] = (bf16)f2bf(-kk); oB[1024 + o] = (bf16)f2bf(kk * al_[blk]); oB[2048 + o] = (bf16)f2bf(kf_[blk]);
                    oB[3072 + o] = (bf16)f2bf(USE_CHUNKED ? r_[blk] : dc_[blk] * r_[blk]); oB[4096 + o] = (bf16)f2bf(v_[blk]);
                }
                if (fr == 0) { SBR[tix] = sbr * inv; SKR[tix] = skr; SBS[tix] = sbs; }
            }
            {
                LDS_WAIT(); __builtin_amdgcn_wave_barrier(); asm volatile("" ::: "memory");
                const LAS float* oW = (const LAS float*)(lds + 8192 + wave * 14336); const LAS bf16* oB = (const LAS bf16*)(oW + 1024);
                const size_t t0x = ((size_t)((m0 / SEQ) * NH + h) * SEQ + (m0 & (SEQ - 1))) * 64;
#pragma unroll
                for (int i = 0; i < 4; ++i) *(f32x4*)(SW + t0x + 4 * (lane + 64 * i)) = *(const LAS f32x4*)(oW + 4 * (lane + 64 * i));
#pragma unroll
                for (int i = 0; i < 2; ++i) { const int e = 8 * (lane + 64 * i);
                    *(v4u*)(SA + t0x + e) = *(const LAS v4u*)(oB + e); *(v4u*)(SB + t0x + e) = *(const LAS v4u*)(oB + 1024 + e); *(v4u*)(SK + t0x + e) = *(const LAS v4u*)(oB + 2048 + e);
                    *(v4u*)(SWR + t0x + e) = *(const LAS v4u*)(oB + 3072 + e); *(v4u*)(SV + t0x + e) = *(const LAS v4u*)(oB + 4096 + e); }
                LDS_WAIT(); __builtin_amdgcn_wave_barrier(); asm volatile("" ::: "memory");
            }
        }
        __syncthreads();
    }
}

__device__ __forceinline__ float reduce16_asm(float x) {
    float r;
    asm("s_nop 1\n\tv_add_f32_dpp %0, %1, %1 quad_perm:[1,0,3,2] row_mask:0xf bank_mask:0xf" : "=v"(r) : "v"(x)); x = r;
    asm("s_nop 1\n\tv_add_f32_dpp %0, %1, %1 quad_perm:[2,3,0,1] row_mask:0xf bank_mask:0xf" : "=v"(r) : "v"(x)); x = r;
    asm("s_nop 1\n\tv_add_f32_dpp %0, %1, %1 row_ror:4 row_mask:0xf bank_mask:0xf" : "=v"(r) : "v"(x)); x = r;
    asm("s_nop 1\n\tv_add_f32_dpp %0, %1, %1 row_ror:8 row_mask:0xf bank_mask:0xf" : "=v"(r) : "v"(x)); return r;
}
__device__ __forceinline__ void reduce16x2_asm(float& x, float& y) {
    asm("s_nop 1\n\t"
        "v_add_f32_dpp %0, %0, %0 quad_perm:[1,0,3,2] row_mask:0xf bank_mask:0xf\n\tv_add_f32_dpp %1, %1, %1 quad_perm:[1,0,3,2] row_mask:0xf bank_mask:0xf\n\ts_nop 0\n\t"
        "v_add_f32_dpp %0, %0, %0 quad_perm:[2,3,0,1] row_mask:0xf bank_mask:0xf\n\tv_add_f32_dpp %1, %1, %1 quad_perm:[2,3,0,1] row_mask:0xf bank_mask:0xf\n\ts_nop 0\n\t"
        "v_add_f32_dpp %0, %0, %0 row_ror:4 row_mask:0xf bank_mask:0xf\n\tv_add_f32_dpp %1, %1, %1 row_ror:4 row_mask:0xf bank_mask:0xf\n\ts_nop 0\n\t"
        "v_add_f32_dpp %0, %0, %0 row_ror:8 row_mask:0xf bank_mask:0xf\n\tv_add_f32_dpp %1, %1, %1 row_ror:8 row_mask:0xf bank_mask:0xf"
        : "+v"(x), "+v"(y));
}
__device__ __forceinline__ void scan_prompt(const PArgs& a, LAS unsigned char* lds, int tid, int lane, int wave, int item) {
    unsigned char* ws = A_WS;
    constexpr int CT = 32, NCH = SEQ / CT, BUFSZ = 5 * 2048 + 512 + 64;
    LAS float* buf0 = (LAS float*)lds; LAS float* ybuf0 = buf0 + 2 * BUFSZ;
    const int bh = item >> 2, rq = item & 3, b = bh >> 4, h = bh & 15;
    if (wave < 4) {
        const int rl = wave * 4 + (lane >> 4), cg = lane & 15;
        f32x2 s01 = {0.f, 0.f}, s23 = {0.f, 0.f};
        __syncthreads();
#pragma unroll 1
        for (int c = 0; c < NCH; ++c) {
            const LAS float* B = buf0 + (c & 1) * BUFSZ; LAS float* yb = ybuf0 + (c & 1) * 512 + rl * 32;
            const LAS float* pc = B + 4 * cg;
            f32x4 cw = *(const LAS f32x4*)pc, ca = *(const LAS f32x4*)(pc + 2048), cb = *(const LAS f32x4*)(pc + 4096), ck = *(const LAS f32x4*)(pc + 6144), cwr = *(const LAS f32x4*)(pc + 8192);
            float cv = B[10240 + rl]; f32x2 csc = *(const LAS f32x2*)(B + 10752);
            f32x4 y4; float yq = 0.f, yz = 0.f;
#pragma unroll 1
            for (int tk4 = 0; tk4 < CT; tk4 += 4) {
#pragma unroll
                for (int u4 = 0; u4 < 4; ++u4) {
                    const int tk = tk4 + u4;
                    const int tn = (tk + 1 < CT) ? tk + 1 : tk;
                    const LAS float* pn = pc + tn * 64;
                    const f32x4 nw = *(const LAS f32x4*)pn, na = *(const LAS f32x4*)(pn + 2048), nb = *(const LAS f32x4*)(pn + 4096), nk = *(const LAS f32x4*)(pn + 6144), nwr = *(const LAS f32x4*)(pn + 8192);
                    const float nv = B[10240 + tn * 16 + rl]; const f32x2 nsc = *(const LAS f32x2*)(B + 10752 + tn * 2);
                    f32x2 p = s01 * (f32x2){ca.x, ca.y}; p = s23 * (f32x2){ca.z, ca.w} + p;
                    f32x2 q = s01 * (f32x2){cwr.x, cwr.y}; q = s23 * (f32x2){cwr.z, cwr.w} + q;
                    const f32x2 b01 = s01 * (f32x2){cw.x, cw.y} + (f32x2){ck.x, ck.y} * cv, b23 = s23 * (f32x2){cw.z, cw.w} + (f32x2){ck.z, ck.w} * cv;
                    float d0 = p.x + p.y, yr = yq;
                    reduce16x2_asm(d0, yr);
                    s01 = (f32x2){cb.x, cb.y} * d0 + b01; s23 = (f32x2){cb.z, cb.w} * d0 + b23;
                    const float yprev = yr + yz;
                    if (u4 == 0) { if (tk4 > 0) { y4[3] = yprev; if (cg == 0) *(LAS f32x4*)(yb + tk4 - 4) = y4; } } else y4[u4 - 1] = yprev;
                    yq = q.x + q.y; yz = d0 * csc.x + cv * csc.y;
                    cw = nw; ca = na; cb = nb; ck = nk; cwr = nwr; cv = nv; csc = nsc;
                }
            }
            { float dmy = 0.f; reduce16x2_asm(yq, dmy); y4[3] = yq + yz; if (cg == 0) *(LAS f32x4*)(yb + CT - 4) = y4; }
            LDS_WAIT(); __syncthreads();
        }
        float* so = A_OUT + O_WKP + ((size_t)bh * 64 + rq * 16 + rl) * 64 + 4 * cg;
        *(f32x4*)so = (f32x4){s01.x, s01.y, s23.x, s23.y};
    } else {
        const float* SW = (const float*)(ws + WS_SW); const bf16* SA = (const bf16*)(ws + WS_SA); const bf16* SB = (const bf16*)(ws + WS_SB); const bf16* SK = (const bf16*)(ws + WS_SK);
        const bf16* SWR = (const bf16*)(ws + WS_SWR); const bf16* SV = (const bf16*)(ws + WS_SV);
        const float* SBR = (const float*)(ws + WS_SBR); const float* SKR = (const float*)(ws + WS_SKR);
        float* YS = A_OUT;
        const int ht = tid - 256, tok = ht >> 3, p8 = ht & 7;
        const size_t g0 = (size_t)bh * SEQ * 64 + (size_t)ht * 8;
#define H_CVT8(dst, u) do { *(LAS f32x4*)(dst) = (f32x4){bflo((u).x), bfhi((u).x), bflo((u).y), bfhi((u).y)}; *(LAS f32x4*)((dst) + 4) = (f32x4){bflo((u).z), bfhi((u).z), bflo((u).w), bfhi((u).w)}; } while (0)
#define H_LOAD(c_) do { const size_t g_ = g0 + (size_t)(c_) * CT * 64; \
        w0_ = *(const f32x4*)(SW + g_); w1_ = *(const f32x4*)(SW + g_ + 4); a_ = *(const v4u*)(SA + g_); b_ = *(const v4u*)(SB + g_); k_ = *(const v4u*)(SK + g_); r_ = *(const v4u*)(SWR + g_); \
        v_ = *(const unsigned*)(SV + ((size_t)bh * SEQ + (c_) * CT + tok) * 64 + rq * 16 + 2 * p8); \
        if (ht < CT) { sc_.x = SBR[(size_t)bh * SEQ + (c_) * CT + ht]; sc_.y = SKR[(size_t)bh * SEQ + (c_) * CT + ht]; } } while (0)
#define H_PUT(B_) do { LAS float* d_ = (B_) + ht * 8; *(LAS f32x4*)d_ = w0_; *(LAS f32x4*)(d_ + 4) = w1_; H_CVT8(d_ + 2048, a_); H_CVT8(d_ + 4096, b_); H_CVT8(d_ + 6144, k_); H_CVT8(d_ + 8192, r_); \
        *(LAS f32x2*)((B_) + 10240 + tok * 16 + 2 * p8) = (f32x2){bflo(v_), bfhi(v_)}; if (ht < CT) *(LAS f32x2*)((B_) + 10752 + ht * 2) = sc_; } while (0)
#define H_YOUT(c_) do { const LAS float* yb_ = ybuf0 + ((c_) & 1) * 512; const f32x2 y_ = {yb_[(2 * p8) * 32 + tok], yb_[(2 * p8 + 1) * 32 + tok]}; \
        *(f32x2*)(YS + ((size_t)b * SEQ + (c_) * CT + tok) * DA + h * 64 + rq * 16 + 2 * p8) = y_; } while (0)
        f32x4 w0_, w1_; v4u a_, b_, k_, r_; unsigned v_; f32x2 sc_ = {0.f, 0.f};
        H_LOAD(0); H_PUT(buf0);
        H_LOAD(1);
        LDS_WAIT(); __syncthreads();
#pragma unroll 1
        for (int c = 0; c < NCH; ++c) {
            if (c + 1 < NCH) H_PUT(buf0 + ((c + 1) & 1) * BUFSZ);
            if (c + 2 < NCH) H_LOAD(c + 2);
            if (c >= 1) H_YOUT(c - 1);
            LDS_WAIT(); __syncthreads();
        }
        H_YOUT(NCH - 1);
#undef H_CVT8
#undef H_LOAD
#undef H_PUT
#undef H_YOUT
    }
    LDS_WAIT(); __syncthreads();
}
constexpr int CLD = 72, CMAT = 64 * CLD;
#define CSLOT(i) ((LAS bf16*)lds + (i) * CMAT)
__device__ __forceinline__ bf16x8 ldf(const LAS bf16* p) { return *(const LAS bf16x8*)p; }
__device__ __forceinline__ bf16x8 ldf(const bf16* p) { return *(const bf16x8*)p; }
template <class PA, class PB> __device__ __forceinline__ f32x4 mm_tile(PA A, int lda, PB Bt, int ldb, int tr, int tc, int fr, int fq, f32x4 acc) {
    PA ap = A + (16 * tr + fr) * lda + 8 * fq; PB bp = Bt + (16 * tc + fr) * ldb + 8 * fq;
    acc = __builtin_amdgcn_mfma_f32_16x16x32_bf16(ldf(ap), ldf(bp), acc, 0, 0, 0);
    acc = __builtin_amdgcn_mfma_f32_16x16x32_bf16(ldf(ap + 32), ldf(bp + 32), acc, 0, 0, 0);
    return acc;
}
__device__ __forceinline__ v2u pack4(const f32x4 v) { return (v2u){pk2(v.x, v.y), pk2(v.z, v.w)}; }
struct ChunkIn { v4u r, k, v, x0, x1, q0, q1, pv; float c[6]; };
__device__ __forceinline__ void chunk_in_load(ChunkIn& x, const PArgs& a, int item, int tid) {
    const bf16* PS = (const bf16*)(A_WS + WS_PS);
    const int bh = item >> 5, c = item & 31, b = bh >> 4, h = bh & 15; const size_t m0 = (size_t)b * SEQ + (size_t)c * 64;
    const bf16* p = PS + (m0 + (tid >> 3)) * PSW + h * 64 + 8 * (tid & 7);
    x.r = *(const v4u*)p; x.k = *(const v4u*)(p + 1024); x.v = *(const v4u*)(p + 2048);
    const bf16* q = PS + (m0 + (tid >> 4)) * PSW + 3072 + 8 * (tid & 15);
    x.x0 = *(const v4u*)q; x.x1 = *(const v4u*)(q + (size_t)32 * PSW);
    x.q1 = *(const v4u*)(q + (size_t)31 * PSW);
    x.q0 = (v4u){0u, 0u, 0u, 0u}; if (c > 0 || tid >= 16) x.q0 = *(const v4u*)(q - PSW);
    x.pv = (v4u){0u, 0u, 0u, 0u};
    if (c > 0 && tid < 24) x.pv = *(const v4u*)(PS + (m0 - 1) * PSW + (tid >> 3) * 1024 + h * 64 + 8 * (tid & 7));
    const int ch = h * 64 + (tid & 63); const float* mu = A_IN(I_MU);
    x.c[0] = mu[ch]; x.c[1] = mu[1024 + ch]; x.c[2] = mu[2048 + ch]; x.c[3] = A_IN(I_KK)[ch]; x.c[4] = A_IN(I_KA)[ch]; x.c[5] = A_IN(I_RK)[ch];
}
struct LoraW { bf16x8 lb[4][2]; float c0[4]; };
__device__ __forceinline__ void lora_load(LoraW& x, const PArgs& a, int item, int tid) {
    const int h = (item >> 5) & 15, mat = tid >> 8, fr = tid & 15, fq = (tid >> 4) & 3;
    const bf16* LT = (const bf16*)(A_WS + (mat ? WS_ALT : WS_WLT)) + (size_t)(h * 64 + fr) * 64 + 8 * fq; const float* cz = mat ? A_IN(I_A0) : A_IN(I_W0);
#pragma unroll
    for (int tc = 0; tc < 4; ++tc) { x.lb[tc][0] = *(const bf16x8*)(LT + (size_t)16 * tc * 64); x.lb[tc][1] = *(const bf16x8*)(LT + (size_t)16 * tc * 64 + 32); x.c0[tc] = cz[h * 64 + 16 * tc + fr]; }
}
__device__ __forceinline__ void chunk_pre(const PArgs& a, LAS unsigned char* lds, int tid, int lane, int wave, int item, const ChunkIn& in, bool dry, LoraW& lw, int item_next) {
    unsigned char* ws = A_WS;
    const size_t base = ((size_t)(item >> 5) * SEQ + (size_t)(item & 31) * 64) * 64;
    float* SWp = (float*)(ws + WS_SW) + base; bf16* SAp = (bf16*)(ws + WS_SA) + base; bf16* SBp = (bf16*)(ws + WS_SB) + base; bf16* SKp = (bf16*)(ws + WS_SK) + base;
    bf16* SRp = (bf16*)(ws + WS_SWR) + base;
    LAS bf16* At = CSLOT(0); LAS bf16* Bt = CSLOT(1); LAS bf16* Kt = CSLOT(2); LAS bf16* Rt = CSLOT(3); LAS bf16* AtT = CSLOT(4); LAS bf16* BtT = CSLOT(5); LAS bf16* KtT = CSLOT(6); LAS bf16* VT = CSLOT(7);
    LAS bf16* Lak = CSLOT(10); LAS bf16* Mrb = CSLOT(11); LAS bf16* Mrk = CSLOT(12);
    LAS float* gC = (LAS float*)(lds + 15 * CMAT * 2);
    const int fr = lane & 15, fq = lane >> 4, tr = wave >> 1, tc0 = 2 * (wave & 1);
    {
        LAS bf16* Rr = CSLOT(8); LAS bf16* Kr = CSLOT(9); LAS bf16* Vr = CSLOT(10); LAS bf16* Aw = CSLOT(0); LAS bf16* Aa = CSLOT(1);
        LAS float* DC = (LAS float*)CSLOT(11); LAS float* AL = (LAS float*)CSLOT(13);
        LAS float* gp = (LAS float*)(lds + 15 * CMAT * 2 + 256); const LAS float* mux = gp + 512;
        const int bh_ = item >> 5, h_ = bh_ & 15;
        {
            const int row = tid >> 3, part = tid & 7;
            *(LAS v4u*)(Rr + (row + 1) * 64 + 8 * part) = in.r; *(LAS v4u*)(Kr + (row + 1) * 64 + 8 * part) = in.k; *(LAS v4u*)(Vr + (row + 1) * 64 + 8 * part) = in.v;
            if (tid < 24) { LAS bf16* d_ = tid < 8 ? Rr : (tid < 16 ? Kr : Vr); *(LAS v4u*)(d_ + 8 * (tid & 7)) = in.pv; }
            const int xr = tid >> 4, cb = (tid & 15) * 8;
            const f32x4 m0_ = *(const LAS f32x4*)(mux + cb), m1_ = *(const LAS f32x4*)(mux + cb + 4);
            const float mm[8] = {m0_.x, m0_.y, m0_.z, m0_.w, m1_.x, m1_.y, m1_.z, m1_.w};
            LAS bf16* dst = cb < 64 ? Aw + xr * CLD + cb : Aa + xr * CLD + (cb - 64);
#pragma unroll
            for (int hf = 0; hf < 2; ++hf) { const v4u cv_ = hf ? in.x1 : in.x0, pv_ = hf ? in.q1 : in.q0;
                const unsigned cw_[4] = {cv_.x, cv_.y, cv_.z, cv_.w}, pw_[4] = {pv_.x, pv_.y, pv_.z, pv_.w}; unsigned ow_[4];
#pragma unroll
                for (int i = 0; i < 4; ++i) { const float ca = bflo(cw_[i]), cbv = bfhi(cw_[i]);
                    float xa_ = ca + mm[2 * i] * (bflo(pw_[i]) - ca), xb_ = cbv + mm[2 * i + 1] * (bfhi(pw_[i]) - cbv);
                    if (cb < 64) { xa_ = tanh_fast(xa_); xb_ = tanh_fast(xb_); }
                    ow_[i] = pk2(xa_, xb_); }
                *(LAS v4u*)(dst + hf * 32 * CLD) = (v4u){ow_[0], ow_[1], ow_[2], ow_[3]}; }
        }
        const int mat = wave >> 2, sr_ = wave & 3;
        LDS_BAR();
        {
            const LAS bf16* Am = (mat ? Aa : Aw) + (16 * sr_ + fr) * CLD + 8 * fq;
            const bf16x8 a0 = ldf(Am), a1 = ldf(Am + 32);
            f32x4 lacc[4];
#pragma unroll
            for (int tc = 0; tc < 4; ++tc) { lacc[tc] = __builtin_amdgcn_mfma_f32_16x16x32_bf16(a0, lw.lb[tc][0], (f32x4){0.f, 0.f, 0.f, 0.f}, 0, 0, 0); lacc[tc] = __builtin_amdgcn_mfma_f32_16x16x32_bf16(a1, lw.lb[tc][1], lacc[tc], 0, 0, 0); }
            LAS float* D_ = mat ? AL : DC;
#pragma unroll
            for (int tc = 0; tc < 4; ++tc)
#pragma unroll
                for (int reg = 0; reg < 4; ++reg) { const float sg_ = sigm(lw.c0[tc] + lacc[tc][reg]); D_[(16 * sr_ + 4 * fq + reg) * 68 + 16 * tc + fr] = mat ? sg_ : __expf(-0.6065306597126334f * sg_); }
        }
        LDS_BAR();
        const int j = lane, t0 = wave * 8;
        float wv[8], al_[8]; unsigned short ur[9], uk[9], uv[9];
#pragma unroll
        for (int i = 0; i < 8; ++i) { wv[i] = DC[(t0 + i) * 68 + j]; al_[i] = AL[(t0 + i) * 68 + j]; }
#pragma unroll
        for (int i = 0; i < 9; ++i) { const int o = (t0 + i) * 64 + j; ur[i] = Rr[o]; uk[i] = Kr[o]; uv[i] = Vr[o]; }
        float pl = wv[0];
#pragma unroll
        for (int i = 1; i < 8; ++i) pl *= wv[i];
        gp[wave * 64 + j] = pl;
        float r_[8], kf_[8], kq_[8], n2_[8], sb_[8]; unsigned xv[4];
        {   float pR = bf1(ur[0]), pK = bf1(uk[0]), pV = bf1(uv[0]);
            bf16* SVp = (bf16*)(ws + WS_SV) + base;
#pragma unroll
            for (int i = 0; i < 8; ++i) { const float cr = bf1(ur[i + 1]), ck = bf1(uk[i + 1]), cv = bf1(uv[i + 1]);
                const float r = cr + in.c[0] * (pR - cr), k = ck + in.c[1] * (pK - ck), v = cv + in.c[2] * (pV - cv);
                pR = cr; pK = ck; pV = cv;
                const float kkr = k * in.c[3], kf = k * (1.0f + (al_[i] - 1.0f) * in.c[4]);
                r_[i] = r; kf_[i] = kf; kq_[i] = kkr; n2_[i] = kkr * kkr; sb_[i] = r * kf * in.c[5];
                const unsigned vb = f2bf(v); if (i & 1) xv[i >> 1] |= vb << 16; else xv[i >> 1] = vb;
                if (!dry) SVp[(t0 + i) * 64 + j] = (bf16)vb; }
#pragma unroll
            for (int i = 0; i < 8; ++i) { n2_[i] = reduce16(n2_[i]); sb_[i] = reduce16(sb_[i]); }
#pragma unroll
            for (int i = 0; i < 8; ++i) { n2_[i] = row_sum4(n2_[i]); sb_[i] = row_sum4(sb_[i]); }
        }
        LDS_BAR();
        float g = 1.f;
#pragma unroll
        for (int q = 0; q < 7; ++q) { const float x = gp[q * 64 + j]; g *= (q < wave) ? x : 1.f; }
        f32x4 xa[2], xb[2], xk[2]; float sbk = 0.f;
#pragma unroll
        for (int i = 0; i < 8; ++i) {
            const int t = t0 + i;
            const float kk = kq_[i] * __builtin_amdgcn_rsqf(fmaxf(n2_[i], 1e-24f));
            sbk = (lane == i) ? sb_[i] : sbk;
            const float gprev = g; g *= wv[i]; const float inv = __builtin_amdgcn_rcpf(g);
            const float av = -kk * gprev, bv = kk * al_[i] * inv, kv = kf_[i] * inv, rv = r_[i] * g;
            At[t * CLD + j] = (bf16)f2bf(av); Bt[t * CLD + j] = (bf16)f2bf(bv); Kt[t * CLD + j] = (bf16)f2bf(kv); Rt[t * CLD + j] = (bf16)f2bf(rv);
            xa[i >> 2][i & 3] = av; xb[i >> 2][i & 3] = bv; xk[i >> 2][i & 3] = kv;
        }
        if (!dry && lane < 8) ((float*)(ws + WS_SBS))[(size_t)bh_ * SEQ + (size_t)(item & 31) * 64 + t0 + lane] = sbk;
        const v2u a0 = pack4(xa[0]), a1 = pack4(xa[1]), b0 = pack4(xb[0]), b1 = pack4(xb[1]), k0 = pack4(xk[0]), k1 = pack4(xk[1]);
        *(LAS v4u*)(AtT + j * CLD + t0) = (v4u){a0.x, a0.y, a1.x, a1.y}; *(LAS v4u*)(BtT + j * CLD + t0) = (v4u){b0.x, b0.y, b1.x, b1.y};
        *(LAS v4u*)(KtT + j * CLD + t0) = (v4u){k0.x, k0.y, k1.x, k1.y}; *(LAS v4u*)(VT + j * CLD + t0) = (v4u){xv[0], xv[1], xv[2], xv[3]};
        if (wave == 7) gC[j] = g;
    }
    LDS_BAR();
    const f32x4 Z4 = {0.f, 0.f, 0.f, 0.f};
    const int sr = wave & 3, sg = wave >> 2, tb = 16 * sr + 4 * fq;
#define STRIP(acc_, A_, B_) do { int oa_ = (16 * sr + fr) * CLD + 8 * fq, ob_ = fr * CLD + 8 * fq; asm volatile("" : "+v"(oa_), "+v"(ob_)); \
        const bf16x8 a0_ = ldf((A_) + oa_), a1_ = ldf((A_) + oa_ + 32); \
        _Pragma("unroll") for (int tc_ = 0; tc_ < 4; ++tc_) { const LAS bf16* bp_ = (B_) + ob_ + 16 * tc_ * CLD; \
            acc_[tc_] = __builtin_amdgcn_mfma_f32_16x16x32_bf16(a0_, ldf(bp_), acc_[tc_], 0, 0, 0); acc_[tc_] = __builtin_amdgcn_mfma_f32_16x16x32_bf16(a1_, ldf(bp_ + 32), acc_[tc_], 0, 0, 0); } } while (0)
#define STRIP2(acc1_, acc2_, A1_, A2_, B_) do { int oa_ = (16 * sr + fr) * CLD + 8 * fq, ob_ = fr * CLD + 8 * fq; asm volatile("" : "+v"(oa_), "+v"(ob_)); \
        const bf16x8 a0_ = ldf((A1_) + oa_), a1_ = ldf((A1_) + oa_ + 32), a2_ = ldf((A2_) + oa_), a3_ = ldf((A2_) + oa_ + 32); \
        _Pragma("unroll") for (int tc_ = 0; tc_ < 4; ++tc_) { const LAS bf16* bp_ = (B_) + ob_ + 16 * tc_ * CLD; const bf16x8 b0_ = ldf(bp_), b1_ = ldf(bp_ + 32); \
            acc1_[tc_] = __builtin_amdgcn_mfma_f32_16x16x32_bf16(a0_, b0_, acc1_[tc_], 0, 0, 0); acc1_[tc_] = __builtin_amdgcn_mfma_f32_16x16x32_bf16(a1_, b1_, acc1_[tc_], 0, 0, 0); \
            acc2_[tc_] = __builtin_amdgcn_mfma_f32_16x16x32_bf16(a2_, b0_, acc2_[tc_], 0, 0, 0); acc2_[tc_] = __builtin_amdgcn_mfma_f32_16x16x32_bf16(a3_, b1_, acc2_[tc_], 0, 0, 0); } } while (0)
    LAS bf16* Xc = CSLOT(8); LAS bf16* XTc = CSLOT(9); LAS bf16* TTc = CSLOT(13);
    int ow = tb * CLD + fr, ot = fr * CLD + tb;
#define OPQ() asm volatile("" : "+v"(ow), "+v"(ot))
    OPQ();
    {
        if (sg == 0) {
            f32x4 c1[4] = {Z4, Z4, Z4, Z4}, c2[4] = {Z4, Z4, Z4, Z4}, c3[4] = {Z4, Z4, Z4, Z4};
            STRIP(c1, At, Bt); STRIP2(c2, c3, Bt, Kt, At);
#pragma unroll
            for (int tc = 0; tc < 4; ++tc) { const int c = 16 * tc + fr; f32x4 x, t1, xr, lk;
#pragma unroll
                for (int reg = 0; reg < 4; ++reg) { const int r = tb + reg; x[reg] = c < r ? c1[tc][reg] : 0.f; t1[reg] = x[reg] + (c == r ? 1.f : 0.f); xr[reg] = r < c ? c2[tc][reg] : 0.f; lk[reg] = r < c ? c3[tc][reg] : 0.f; }
                *(LAS v2u*)(XTc + ot + 16 * tc * CLD) = pack4(x); *(LAS v2u*)(TTc + ot + 16 * tc * CLD) = pack4(t1);
                *(LAS v2u*)(Xc + ot + 16 * tc * CLD) = pack4(xr); *(LAS v2u*)(Lak + ot + 16 * tc * CLD) = pack4(lk); }
        } else {
            f32x4 c4[4] = {Z4, Z4, Z4, Z4}, c5[4] = {Z4, Z4, Z4, Z4};
            STRIP2(c4, c5, Bt, Kt, Rt);
#pragma unroll
            for (int tc = 0; tc < 4; ++tc) { const int c = 16 * tc + fr; f32x4 mb, mk;
#pragma unroll
                for (int reg = 0; reg < 4; ++reg) { const int r = tb + reg; mb[reg] = r <= c ? c4[tc][reg] : 0.f; mk[reg] = r <= c ? c5[tc][reg] : 0.f; }
                *(LAS v2u*)(Mrb + ot + 16 * tc * CLD) = pack4(mb); *(LAS v2u*)(Mrk + ot + 16 * tc * CLD) = pack4(mk); }
        }
    }
    LDS_BAR(); OPQ();
    LAS bf16* Xn = CSLOT(1); LAS bf16* XTn = CSLOT(2); LAS bf16* TTn = CSLOT(0);
    LAS bf16* W2T = CSLOT(14);
    {   f32x4 r_[4] = {Z4, Z4, Z4, Z4};
        if (sg == 0) { f32x4 q_[4] = {Z4, Z4, Z4, Z4};
            STRIP(r_, Xc, XTc); STRIP(q_, XTc, Xc);
#pragma unroll
            for (int tc = 0; tc < 4; ++tc) { *(LAS v2u*)(XTn + ot + 16 * tc * CLD) = pack4(r_[tc]); *(LAS v2u*)(Xn + ot + 16 * tc * CLD) = pack4(q_[tc]); }
        } else { STRIP(r_, Lak, VT);
#pragma unroll
            for (int tc = 0; tc < 4; ++tc) *(LAS v2u*)(W2T + ot + 16 * tc * CLD) = pack4(r_[tc]); }
    }
    LDS_BAR(); OPQ();
    { LAS bf16* t_ = Xc; Xc = Xn; Xn = t_; t_ = XTc; XTc = XTn; XTn = t_; }
#pragma unroll
    for (int it = 1; it <= 4; ++it) {
        f32x4 r_[4] = {Z4, Z4, Z4, Z4};
        if (sg == 0) { STRIP(r_, Xc, TTc);
#pragma unroll
            for (int tc = 0; tc < 4; ++tc) { const v2u told = *(const LAS v2u*)(TTc + ot + 16 * tc * CLD); f32x4 y = r_[tc];
                y[0] += bflo(told.x); y[1] += bfhi(told.x); y[2] += bflo(told.y); y[3] += bfhi(told.y);
                *(LAS v2u*)(TTn + ot + 16 * tc * CLD) = pack4(y); }
        } else { f32x4 q_[4] = {Z4, Z4, Z4, Z4};
            STRIP(r_, Xc, XTc); STRIP(q_, XTc, Xc);
#pragma unroll
            for (int tc = 0; tc < 4; ++tc) { *(LAS v2u*)(XTn + ot + 16 * tc * CLD) = pack4(r_[tc]); *(LAS v2u*)(Xn + ot + 16 * tc * CLD) = pack4(q_[tc]); }
        }
        LDS_BAR(); OPQ();
        { LAS bf16* t_ = Xc; Xc = Xn; Xn = t_; t_ = XTc; XTc = XTn; XTn = t_; t_ = TTc; TTc = TTn; TTn = t_; }
    }
    LAS bf16* Trm = CSLOT(10);
    {   const bf16x8 a0 = ldf(TTc + (16 * sr + fr) * CLD + 8 * fq), a1 = ldf(TTc + (16 * sr + fr) * CLD + 8 * fq + 32);
#pragma unroll
        for (int ti = 0; ti < 2; ++ti) { const int tc = 2 * sg + ti; const LAS bf16* bp = Xc + (16 * tc + fr) * CLD + 8 * fq;
            f32x4 y = __builtin_amdgcn_mfma_f32_16x16x32_bf16(a0, ldf(bp), Z4, 0, 0, 0); y = __builtin_amdgcn_mfma_f32_16x16x32_bf16(a1, ldf(bp + 32), y, 0, 0, 0);
#pragma unroll
            for (int reg = 0; reg < 4; ++reg) y[reg] += bf1(TTc[ow + reg * CLD + 16 * tc]);
            *(LAS v2u*)(Trm + ot + 16 * tc * CLD) = pack4(y); }
    }
    LDS_BAR(); OPQ();
    LAS bf16* G1T = Xn; LAS bf16* G2T = XTn;
    {   f32x4 r_[4] = {Z4, Z4, Z4, Z4};
        if (sg == 0) STRIP(r_, Trm, AtT); else STRIP(r_, Trm, W2T);
        LAS bf16* dst = sg == 0 ? G1T : G2T;
#pragma unroll
        for (int tc = 0; tc < 4; ++tc) *(LAS v2u*)(dst + ot + 16 * tc * CLD) = pack4(r_[tc]);
    }
    LDS_BAR(); OPQ();
    {
        LAS bf16* oPh = CSLOT(0); LAS bf16* oQ = CSLOT(2); LAS bf16* oRy = CSLOT(4); LAS bf16* oY0 = CSLOT(1);
        f32x4 u_[4] = {Z4, Z4, Z4, Z4}, v_[4] = {Z4, Z4, Z4, Z4};
        if (sg == 0) { STRIP(u_, G1T, BtT); STRIP(v_, BtT, G2T); STRIP(v_, KtT, VT); } else { STRIP(u_, G1T, Mrb); STRIP(v_, Mrb, G2T); STRIP(v_, Mrk, VT); }
#pragma unroll
        for (int tc = 0; tc < 4; ++tc) { const int c = 16 * tc + fr, fo = ((2 * sr + (tc >> 1)) * 64 + lane) * 8 + (tc & 1) * 4;
            if (sg == 0) { f32x4 qv, pv; const float gcc = gC[c];
#pragma unroll
                for (int reg = 0; reg < 4; ++reg) { const int r = tb + reg; pv[reg] = gcc * (u_[tc][reg] + (c == r ? 1.f : 0.f)); qv[reg] = gC[r] * v_[tc][reg]; }
                *(LAS v2u*)(oPh + ot + 16 * tc * CLD) = pack4(pv);
                *(LAS v2u*)(oQ + fo) = pack4(qv);
            } else { const v2u rt = *(const LAS v2u*)(Rt + ot + 16 * tc * CLD); f32x4 y = u_[tc];
                y[0] += bflo(rt.x); y[1] += bfhi(rt.x); y[2] += bflo(rt.y); y[3] += bfhi(rt.y);
                *(LAS v2u*)(oRy + ot + 16 * tc * CLD) = pack4(y);
                *(LAS v2u*)(oY0 + fo) = pack4(v_[tc]); }
        }
#undef STRIP
#undef STRIP2
#undef OPQ
        LDS_BAR();
        lora_load(lw, a, item_next, tid);
        const int e = tid * 8, ep = (tid >> 3) * CLD + (tid & 7) * 8;
        if (!dry) {
        *(v4u*)(SAp + e) = *(const LAS v4u*)(oPh + ep); *(v4u*)(SBp + e) = *(const LAS v4u*)(oY0 + e); *(v4u*)(SKp + e) = *(const LAS v4u*)(oQ + e); *(v4u*)(SRp + e) = *(const LAS v4u*)(oRy + ep); }
    }
    LDS_BAR();
}
struct ChainOps { bf16x8 ry[2], ph[2]; v4u y0, q; };
__device__ __forceinline__ void chain_load(ChainOps& o, const unsigned char* ws, size_t base, int tr, int tc0, int fr, int fq) {
    const bf16* Y0 = (const bf16*)(ws + WS_SB) + base; const bf16* Ph = (const bf16*)(ws + WS_SA) + base;
    const bf16* Qb = (const bf16*)(ws + WS_SK) + base; const bf16* Ry = (const bf16*)(ws + WS_SWR) + base;
    const int ao = (16 * tr + fr) * 64 + 8 * fq;
#pragma unroll
    for (int ks = 0; ks < 2; ++ks) { o.ry[ks] = *(const bf16x8*)(Ry + ao + 32 * ks); o.ph[ks] = *(const bf16x8*)(Ph + ao + 32 * ks); }
    const int fo = ((2 * tr + (tc0 >> 1)) * 64 + fq * 16 + fr) * 8;
    o.y0 = *(const v4u*)(Y0 + fo); o.q = *(const v4u*)(Qb + fo);
}
__device__ __forceinline__ void chunk_chain(const PArgs& a, LAS unsigned char* lds, int tid, int lane, int wave, int bh, bool probe_same) {
    unsigned char* ws = A_WS; bf16* YS = (bf16*)A_OUT;
    LAS bf16* HhT = CSLOT(0); LAS bf16* HlT = CSLOT(1); LAS bf16* ybuf = CSLOT(2);
    for (int i = tid; i < 2 * CMAT / 2; i += NTHR) ((LAS unsigned*)HhT)[i] = 0u;
    const int fr = lane & 15, fq = lane >> 4, tr = wave >> 1, tc0 = 2 * (wave & 1), b = bh >> 4, h = bh & 15;
    const f32x4 Z4 = {0.f, 0.f, 0.f, 0.f};
    f32x4 hn[2] = {Z4, Z4};
    constexpr int NC = SEQ / 64;
    const size_t hb = (size_t)bh * SEQ * 64;
    auto step = [&](const ChainOps& cur, int c) {
#pragma unroll
        for (int ti = 0; ti < 2; ++ti) { const int s = 16 * (tc0 + ti) + fr, tb = 16 * tr + 4 * fq;
            const LAS bf16* hp = HhT + s * CLD + 8 * fq; const LAS bf16* lp = HlT + s * CLD + 8 * fq;
            const bf16x8 hh0 = ldf(hp), hh1 = ldf(hp + 32), hl0 = ldf(lp), hl1 = ldf(lp + 32);
            f32x4 yy = __builtin_amdgcn_mfma_f32_16x16x32_bf16(cur.ry[0], hh0, Z4, 0, 0, 0); yy = __builtin_amdgcn_mfma_f32_16x16x32_bf16(cur.ry[1], hh1, yy, 0, 0, 0);
            yy = __builtin_amdgcn_mfma_f32_16x16x32_bf16(cur.ry[0], hl0, yy, 0, 0, 0); yy = __builtin_amdgcn_mfma_f32_16x16x32_bf16(cur.ry[1], hl1, yy, 0, 0, 0);
            f32x4 hh = __builtin_amdgcn_mfma_f32_16x16x32_bf16(cur.ph[0], hh0, Z4, 0, 0, 0); hh = __builtin_amdgcn_mfma_f32_16x16x32_bf16(cur.ph[1], hh1, hh, 0, 0, 0);
            hh = __builtin_amdgcn_mfma_f32_16x16x32_bf16(cur.ph[0], hl0, hh, 0, 0, 0); hh = __builtin_amdgcn_mfma_f32_16x16x32_bf16(cur.ph[1], hl1, hh, 0, 0, 0);
#pragma unroll
            for (int reg = 0; reg < 4; ++reg) { const int t = tb + reg;
                const unsigned yw = cur.y0[ti * 2 + (reg >> 1)], qw = cur.q[ti * 2 + (reg >> 1)];
                ybuf[t * CLD + s] = (bf16)f2bf(yy[reg] + ((reg & 1) ? bfhi(yw) : bflo(yw)));
                hn[ti][reg] = hh[reg] + ((reg & 1) ? bfhi(qw) : bflo(qw)); }
        }
        LDS_BAR();
#pragma unroll
        for (int ti = 0; ti < 2; ++ti) { const int s = 16 * (tc0 + ti) + fr, tb = 16 * tr + 4 * fq;
            f32x4 hi, lo;
#pragma unroll
            for (int reg = 0; reg < 4; ++reg) { hi[reg] = __uint_as_float(f2bf(hn[ti][reg]) << 16); lo[reg] = hn[ti][reg] - hi[reg]; }
            *(LAS v2u*)(HhT + s * CLD + tb) = pack4(hi); *(LAS v2u*)(HlT + s * CLD + tb) = pack4(lo); }
        *(v4u*)(YS + ((size_t)b * SEQ + c * 64 + (tid >> 3)) * DA + h * 64 + 8 * (tid & 7)) = *(const LAS v4u*)(ybuf + (tid >> 3) * CLD + 8 * (tid & 7));
        LDS_BAR();
    };
    auto cbase = [&](int c) { return hb + (size_t)(probe_same ? 0 : (c < NC ? c : NC - 1)) * 4096; };
    ChainOps o0, o1, o2;
    chain_load(o0, ws, cbase(0), tr, tc0, fr, fq); chain_load(o1, ws, cbase(1), tr, tc0, fr, fq);
    LDS_BAR();
#pragma unroll
    for (int c = 0; c < NC; c += 3) {
        chain_load(o2, ws, cbase(c + 2), tr, tc0, fr, fq); step(o0, c);
        chain_load(o0, ws, cbase(c + 3), tr, tc0, fr, fq); if (c + 1 < NC) step(o1, c + 1);
        chain_load(o1, ws, cbase(c + 4), tr, tc0, fr, fq); if (c + 2 < NC) step(o2, c + 2);
    }
#pragma unroll
    for (int ti = 0; ti < 2; ++ti) { const int s = 16 * (tc0 + ti) + fr, tb = 16 * tr + 4 * fq;
#pragma unroll
        for (int reg = 0; reg < 4; ++reg) A_OUT[O_WKP + ((size_t)bh * 64 + s) * 64 + tb + reg] = hn[ti][reg]; }
    LDS_BAR();
}
__device__ __forceinline__ void oa_token(const PArgs& a, int lane, int m) {
    unsigned char* ws = A_WS; const bf16* YS = (const bf16*)A_OUT; const bf16* SV = (const bf16*)(ws + WS_SV); const float* SBS = (const float*)(ws + WS_SBS);
    const bf16* GA = (const bf16*)(ws + WS_GA); bf16* OA = (bf16*)(ws + WS_OA);
    const int b = m / SEQ, t = m & (SEQ - 1);
#pragma unroll
    for (int q = 0; q < 4; ++q) {
        const int c = 4 * lane + 256 * q, hd = c >> 6, i4 = c & 63; const size_t tix = (size_t)(b * NH + hd) * SEQ + t;
        const v2u yc = *(const v2u*)(YS + (size_t)m * DA + c); const f32x4 y4 = {bflo(yc.x), bfhi(yc.x), bflo(yc.y), bfhi(yc.y)};
        const float mean = reduce16((y4.x + y4.y) + (y4.z + y4.w)) * (1.0f / 64.0f);
        const f32x4 d = y4 - mean;
        const float var = reduce16((d.x * d.x + d.y * d.y) + (d.z * d.z + d.w * d.w)) * (1.0f / 64.0f);
        const float rstd = 1.0f / sqrtf(var + GN_EPS), bs = SBS[tix];
        const v2u vc = *(const v2u*)(SV + tix * 64 + i4), gc = *(const v2u*)(GA + (size_t)m * DA + c);
        const f32x4 v4 = {bflo(vc.x), bfhi(vc.x), bflo(vc.y), bfhi(vc.y)}, g = {bflo(gc.x), bfhi(gc.x), bflo(gc.y), bfhi(gc.y)};
        const f32x4 lng = *(const f32x4*)(A_IN(I_LNXG) + c), lnb = *(const f32x4*)(A_IN(I_LNXB) + c);
        f32x4 o = d * rstd * lng + lnb + bs * v4;
        o.x *= g.x * sigm(g.x); o.y *= g.y * sigm(g.y); o.z *= g.z * sigm(g.z); o.w *= g.w * sigm(g.w);
        *(v2u*)(OA + (size_t)m * OAS + c) = (v2u){pk2(o.x, o.y), pk2(o.z, o.w)};
    }
}
__device__ __forceinline__ void sample_wkv_item(const PArgs& a, LAS float* wscr, int lane, int item) {
    unsigned char* ws = A_WS;
    const bf16* PS = (const bf16*)(ws + WS_PS); const bf16* WlT = (const bf16*)(ws + WS_WLT); const bf16* AlT = (const bf16*)(ws + WS_ALT);
    const bf16* GA = (const bf16*)(ws + WS_GA); bf16* OA = (bf16*)(ws + WS_OA);
    const float* mu = A_IN(I_MU); const float* sst = A_IN(I_SSHIFT);
    const int s = item >> 4, h = item & 15, cg = lane & 15, rp = lane >> 4, ch = h * 64 + lane; const size_t m = (size_t)MP + s;
    const float* S0 = A_IN(I_SWKV) + (size_t)item * 4096; float* S1 = A_OUT + O_WKS + (size_t)item * 4096;
    f32x4 st0[8], st1[8];
#pragma unroll
    for (int ps = 0; ps < 8; ++ps) { const int i0 = ps * 8 + 2 * rp;
        st0[ps] = *(const f32x4*)(S0 + (size_t)i0 * 64 + 4 * cg); st1[ps] = *(const f32x4*)(S0 + (size_t)(i0 + 1) * 64 + 4 * cg); }
    LAS float* xw = wscr; LAS float* xa = wscr + 64; LAS float* tv = wscr + 128;
    { const bf16* pr = PS + m * PSW + 3072 + lane; const float* sr = sst + (size_t)s * SHW + 3072 + lane;
      const float p0 = bf1(pr[0]), p1 = bf1(pr[64]), q0 = sr[0], q1 = sr[64], m0 = mu[3072 + lane], m1 = mu[3136 + lane];
      xw[lane] = tanh_fast(p0 + m0 * (q0 - p0)); xa[lane] = p1 + m1 * (q1 - p1); }
    v4u wl[8], al_[8];
#pragma unroll
    for (int i = 0; i < 8; ++i) { wl[i] = *(const v4u*)(WlT + (size_t)ch * 64 + 8 * i); al_[i] = *(const v4u*)(AlT + (size_t)ch * 64 + 8 * i); }
    const bf16* pr = PS + m * PSW + ch; const float* sr = sst + (size_t)s * SHW + ch;
    const float pR = bf1(pr[0]), pK = bf1(pr[1024]), pV = bf1(pr[2048]), qR = sr[0], qK = sr[1024], qV = sr[2048];
    const float r = pR + mu[ch] * (qR - pR), k = pK + mu[1024 + ch] * (qK - pK), v = pV + mu[2048 + ch] * (qV - pV);
    const float cW0 = A_IN(I_W0)[ch], cA0 = A_IN(I_A0)[ch], cKK = A_IN(I_KK)[ch], cKA = A_IN(I_KA)[ch], cRK = A_IN(I_RK)[ch], cLG = A_IN(I_LNXG)[ch], cLB = A_IN(I_LNXB)[ch], g = bf1(GA[m * DA + ch]);
    LDS_WAIT(); __builtin_amdgcn_wave_barrier(); asm volatile("" ::: "memory");
    float lw = 0.f, la = 0.f;
#pragma unroll
    for (int i = 0; i < 8; ++i) { const f32x4 x0 = *(const LAS f32x4*)(xw + 8 * i), x1 = *(const LAS f32x4*)(xw + 8 * i + 4), y0 = *(const LAS f32x4*)(xa + 8 * i), y1 = *(const LAS f32x4*)(xa + 8 * i + 4);
        lw += (bflo(wl[i].x) * x0.x + bfhi(wl[i].x) * x0.y) + (bflo(wl[i].y) * x0.z + bfhi(wl[i].y) * x0.w) + (bflo(wl[i].z) * x1.x + bfhi(wl[i].z) * x1.y) + (bflo(wl[i].w) * x1.z + bfhi(wl[i].w) * x1.w);
        la += (bflo(al_[i].x) * y0.x + bfhi(al_[i].x) * y0.y) + (bflo(al_[i].y) * y0.z + bfhi(al_[i].y) * y0.w) + (bflo(al_[i].z) * y1.x + bfhi(al_[i].z) * y1.y) + (bflo(al_[i].w) * y1.z + bfhi(al_[i].w) * y1.w); }
    const float dc = __expf(-0.6065306597126334f * sigm(cW0 + lw)), al = sigm(cA0 + la);
    const float kkr = k * cKK, kf = k * (1.0f + (al - 1.0f) * cKA);
    const float inv = 1.0f / fmaxf(sqrtf(wave_sum(kkr * kkr)), 1e-12f), kk = kkr * inv;
    const float br = wave_sum(kk * al * r), kr = wave_sum(kf * r), bs = wave_sum(r * kf * cRK);
    tv[lane] = dc; tv[64 + lane] = -kk; tv[128 + lane] = kk * al; tv[192 + lane] = kf; tv[256 + lane] = dc * r; tv[320 + lane] = v;
    LDS_WAIT(); __builtin_amdgcn_wave_barrier(); asm volatile("" ::: "memory");
    const f32x4 w4 = *(const LAS f32x4*)(tv + 4 * cg), a4 = *(const LAS f32x4*)(tv + 64 + 4 * cg), b4 = *(const LAS f32x4*)(tv + 128 + 4 * cg), k4 = *(const LAS f32x4*)(tv + 192 + 4 * cg),
                wr4 = *(const LAS f32x4*)(tv + 256 + 4 * cg);
    LAS float* yb = tv + 384;
#pragma unroll
    for (int ps = 0; ps < 8; ++ps) {
        const int i0 = ps * 8 + 2 * rp;
        f32x4 s0 = st0[ps], s1 = st1[ps];
        const f32x2 vv = *(const LAS f32x2*)(tv + 320 + i0); const float v0 = vv.x, v1 = vv.y;
        float d00 = 0.f, d01 = 0.f, d10 = 0.f, d11 = 0.f;
#pragma unroll
        for (int e = 0; e < 4; ++e) { d00 += s0[e] * a4[e]; d01 += s0[e] * wr4[e]; d10 += s1[e] * a4[e]; d11 += s1[e] * wr4[e]; }
        d00 = reduce16(d00); d01 = reduce16(d01); d10 = reduce16(d10); d11 = reduce16(d11);
        const float y0 = d01 + d00 * br + v0 * kr, y1 = d11 + d10 * br + v1 * kr;
#pragma unroll
        for (int e = 0; e < 4; ++e) { s0[e] = s0[e] * w4[e] + (d00 * b4[e] + v0 * k4[e]); s1[e] = s1[e] * w4[e] + (d10 * b4[e] + v1 * k4[e]); }
        *(f32x4*)(S1 + (size_t)i0 * 64 + 4 * cg) = s0; *(f32x4*)(S1 + (size_t)(i0 + 1) * 64 + 4 * cg) = s1;
        if (cg == 0) *(LAS f32x2*)(yb + i0) = (f32x2){y0, y1};
    }
    LDS_WAIT(); __builtin_amdgcn_wave_barrier(); asm volatile("" ::: "memory");
    const float y = yb[lane];
    const float mean = wave_sum(y) * (1.0f / 64.0f), d = y - mean, var = wave_sum(d * d) * (1.0f / 64.0f), rstd = 1.0f / sqrtf(var + GN_EPS);
    float o = d * rstd * cLG + cLB + bs * v;
    o *= g * sigm(g);
    OA[m * OAS + ch] = (bf16)f2bf(o);
    LDS_WAIT(); __builtin_amdgcn_wave_barrier(); asm volatile("" ::: "memory");
}
template <int TPW> struct ConvTailOps { f32x4 g[4], bb[4]; v2u gc[TPW][4]; };
template <int TPW> __device__ __forceinline__ void conv_tail_load(ConvTailOps<TPW>& P, const PArgs& a, int lane, int wave, int mrow0) {
    const bf16* GB = (const bf16*)(A_WS + WS_GB); const float* cg_ = A_IN(I_CLNG); const float* cb_ = A_IN(I_CLNB);
#pragma unroll
    for (int q = 0; q < 4; ++q) { const int ch = 4 * lane + 256 * q; P.g[q] = *(const f32x4*)(cg_ + ch); P.bb[q] = *(const f32x4*)(cb_ + ch);
#pragma unroll
        for (int oo = 0; oo < TPW; ++oo) P.gc[oo][q] = *(const v2u*)(GB + ((size_t)mrow0 + wave * TPW + oo) * DA + ch); }
}
template <int TPW> __device__ __forceinline__ void conv_tail(const ConvTailOps<TPW>& P, const PArgs& a, LAS float* cbuf, int lane, int wave, int mrow0) {
    bf16* CB = (bf16*)(A_WS + WS_CB);
#pragma unroll
    for (int oo = 0; oo < TPW; ++oo) {
        const int o = wave * TPW + oo; const size_t m = (size_t)mrow0 + o;
        f32x4 c[4]; float s = 0.f;
#pragma unroll
        for (int q = 0; q < 4; ++q) { c[q] = *(const LAS f32x4*)(cbuf + o * 1024 + 4 * lane + 256 * q); s += (c[q].x + c[q].y) + (c[q].z + c[q].w); }
        const float mean = wave_sum(s) * (1.0f / 1024.0f); float s2 = 0.f;
#pragma unroll
        for (int q = 0; q < 4; ++q) { c[q] = c[q] - mean; s2 += (c[q].x * c[q].x + c[q].y * c[q].y) + (c[q].z * c[q].z + c[q].w * c[q].w); }
        const float rstd = 1.0f / sqrtf(wave_sum(s2) * (1.0f / 1024.0f) + LN_EPS);
#pragma unroll
        for (int q = 0; q < 4; ++q) { const int ch = 4 * lane + 256 * q; const v2u gc = P.gc[oo][q];
            const f32x4 gb = {bflo(gc.x), bfhi(gc.x), bflo(gc.y), bfhi(gc.y)};
            f32x4 y = c[q] * rstd * P.g[q] + P.bb[q];
            y.x = silu2(y.x, gb.x); y.y = silu2(y.y, gb.y); y.z = silu2(y.z, gb.z); y.w = silu2(y.w, gb.w);
            *(v2u*)(CB + m * OAS + ch) = (v2u){pk2(y.x, y.y), pk2(y.z, y.w)}; }
    }
}
__device__ __forceinline__ void conv_prompt_item(const PArgs& a, LAS unsigned char* lds, int tid, int lane, int wave, int item) {
    unsigned char* ws = A_WS; const bf16* GLU = (const bf16*)(ws + WS_GLU);
    LAS float* cbuf = (LAS float*)lds;
    constexpr int CT = 32, NR = CT + CK - 1, NBAT = 2, RB = (NR + NBAT - 1) / NBAT;
    const int b = item >> 6, t0 = (item & 63) * CT, c0 = 2 * tid;
    const float* cw = A_IN(I_CONVW) + c0;
    f32x2 w[CK];
#pragma unroll
    for (int j = 0; j < CK; ++j) w[j] = *(const f32x2*)(cw + (size_t)j * DA);
    const f32x2 bias = *(const f32x2*)(A_IN(I_CONVB) + c0);
    f32x2 acc[CT];
#pragma unroll
    for (int o = 0; o < CT; ++o) acc[o] = bias;
    const bf16* gbase = GLU + (size_t)b * SEQ * 1024 + c0;
    float* ncv = A_OUT + O_CVP + (size_t)b * 30 * DA + c0;
#pragma unroll
    for (int hb = 0; hb < NBAT; ++hb) {
        unsigned av[RB];
#pragma unroll
        for (int i = 0; i < RB; ++i) { const int p = hb * RB + i, t = t0 - 30 + p; if (p < NR) av[i] = *(const unsigned*)(gbase + (size_t)(t < 0 ? 0 : t) * 1024); }
#pragma unroll
        for (int i = 0; i < RB; ++i) {
            const int p = hb * RB + i, t = t0 - 30 + p;
            if (p < NR) {
                f32x2 u = {bflo(av[i]), bfhi(av[i])};
                if (t < 0) u = (f32x2){0.f, 0.f};
                if (t0 == SEQ - CT && p >= CT) *(f32x2*)(ncv + (size_t)(p - CT) * DA) = u;
#pragma unroll
                for (int j = 0; j < CK; ++j) { const int o = p - j; if (o >= 0 && o < CT) acc[o] += w[j] * u; }
            }
        }
    }
#pragma unroll
    for (int o = 0; o < CT; ++o) *(LAS f32x2*)(cbuf + o * 1024 + c0) = acc[o];
    ConvTailOps<CT / NWAVES> tl; conv_tail_load<CT / NWAVES>(tl, a, lane, wave, b * SEQ + t0);
    LDS_BAR();
    conv_tail<CT / NWAVES>(tl, a, cbuf, lane, wave, b * SEQ + t0);
    LDS_WAIT(); __syncthreads();
}
__device__ __forceinline__ void conv_sample_wg(const PArgs& a, LAS float* st_, int lane, int wave, int item) {
    unsigned char* ws = A_WS; const bf16* GLU = (const bf16*)(ws + WS_GLU); const bf16* GB = (const bf16*)(ws + WS_GB); bf16* CB = (bf16*)(ws + WS_CB);
    const int sidx = 2 * item + (wave >> 2), ch = 4 * lane + 256 * (wave & 3);
    const float* cw = A_IN(I_CONVW) + ch; const float* st = A_IN(I_SCONV) + (size_t)sidx * 30 * DA + ch; float* no = A_OUT + O_CVS + (size_t)sidx * 30 * DA + ch;
    const size_t m = (size_t)MP + sidx;
    f32x4 acc = *(const f32x4*)(A_IN(I_CONVB) + ch);
#pragma unroll 1
    for (int hf = 0; hf < 2; ++hf) {
        f32x4 x[15], w[15];
#pragma unroll
        for (int i = 0; i < 15; ++i) { const int j = hf * 15 + i; x[i] = *(const f32x4*)(st + (size_t)j * DA); w[i] = *(const f32x4*)(cw + (size_t)j * DA); }
#pragma unroll
        for (int i = 0; i < 15; ++i) { const int j = hf * 15 + i; acc += w[i] * x[i]; if (j >= 1) *(f32x4*)(no + (size_t)(j - 1) * DA) = x[i]; }
    }
    const v2u av = *(const v2u*)(GLU + m * 1024 + ch);
    const f32x4 u = {bflo(av.x), bfhi(av.x), bflo(av.y), bfhi(av.y)};
    acc += *(const f32x4*)(cw + (size_t)30 * DA) * u; *(f32x4*)(no + (size_t)29 * DA) = u;
    const float s1 = wave_sum((acc.x + acc.y) + (acc.z + acc.w)), s2 = wave_sum((acc.x * acc.x + acc.y * acc.y) + (acc.z * acc.z + acc.w * acc.w));
    if (lane == 0) { st_[wave * 2] = s1; st_[wave * 2 + 1] = s2; }
    LDS_WAIT(); __syncthreads();
    const int w0 = (wave >> 2) * 4;
    const float t1 = (st_[w0 * 2] + st_[w0 * 2 + 2]) + (st_[w0 * 2 + 4] + st_[w0 * 2 + 6]), t2 = (st_[w0 * 2 + 1] + st_[w0 * 2 + 3]) + (st_[w0 * 2 + 5] + st_[w0 * 2 + 7]);
    const float mean = t1 * (1.0f / 1024.0f), rstd = 1.0f / sqrtf(fmaxf(t2 * (1.0f / 1024.0f) - mean * mean, 0.f) + LN_EPS);
    const f32x4 g = *(const f32x4*)(A_IN(I_CLNG) + ch), bb = *(const f32x4*)(A_IN(I_CLNB) + ch); const v2u gc = *(const v2u*)(GB + m * DA + ch);
    const f32x4 gb = {bflo(gc.x), bfhi(gc.x), bflo(gc.y), bfhi(gc.y)};
    f32x4 y = (acc - mean) * rstd * g + bb;
    y.x = (y.x * sigm(y.x)) * (gb.x * sigm(gb.x)); y.y = (y.y * sigm(y.y)) * (gb.y * sigm(gb.y)); y.z = (y.z * sigm(y.z)) * (gb.z * sigm(gb.z)); y.w = (y.w * sigm(y.w)) * (gb.w * sigm(gb.w));
    *(v2u*)(CB + m * OAS + ch) = (v2u){pk2(y.x, y.y), pk2(y.z, y.w)};
    LDS_WAIT(); __syncthreads();
}
__device__ __forceinline__ void conv_sample_one(const PArgs& a, LAS float* st_, int lane, int wave, int sidx) {
    unsigned char* ws = A_WS; const bf16* GLU = (const bf16*)(ws + WS_GLU); const bf16* GB = (const bf16*)(ws + WS_GB); bf16* CB = (bf16*)(ws + WS_CB);
    const int ch = 2 * lane + 128 * wave;
    const float* cw = A_IN(I_CONVW) + ch; const float* st = A_IN(I_SCONV) + (size_t)sidx * 30 * DA + ch; float* no = A_OUT + O_CVS + (size_t)sidx * 30 * DA + ch;
    const size_t m = (size_t)MP + sidx;
    f32x2 acc = *(const f32x2*)(A_IN(I_CONVB) + ch);
    const unsigned av = *(const unsigned*)(GLU + m * 1024 + ch), gc = *(const unsigned*)(GB + m * DA + ch);
    const f32x2 g = *(const f32x2*)(A_IN(I_CLNG) + ch), bb = *(const f32x2*)(A_IN(I_CLNB) + ch), w30 = *(const f32x2*)(cw + (size_t)30 * DA);
#pragma unroll 1
    for (int hf = 0; hf < 2; ++hf) {
        f32x2 x[15], w[15];
#pragma unroll
        for (int i = 0; i < 15; ++i) { const int j = hf * 15 + i; x[i] = *(const f32x2*)(st + (size_t)j * DA); w[i] = *(const f32x2*)(cw + (size_t)j * DA); }
#pragma unroll
        for (int i = 0; i < 15; ++i) { const int j = hf * 15 + i; acc += w[i] * x[i]; if (j >= 1) *(f32x2*)(no + (size_t)(j - 1) * DA) = x[i]; }
    }
    const f32x2 u = {bflo(av), bfhi(av)};
    acc += w30 * u; *(f32x2*)(no + (size_t)29 * DA) = u;
    const float s1 = wave_sum(acc.x + acc.y), s2 = wave_sum(acc.x * acc.x + acc.y * acc.y);
    if (lane == 0) { st_[wave * 2] = s1; st_[wave * 2 + 1] = s2; }
    LDS_WAIT(); __syncthreads();
    float t1 = 0.f, t2 = 0.f;
#pragma unroll
    for (int w = 0; w < 8; ++w) { t1 += st_[w * 2]; t2 += st_[w * 2 + 1]; }
    const float mean = t1 * (1.0f / 1024.0f), rstd = 1.0f / sqrtf(fmaxf(t2 * (1.0f / 1024.0f) - mean * mean, 0.f) + LN_EPS);
    const f32x2 y = (acc - mean) * rstd * g + bb;
    *(unsigned*)(CB + m * OAS + ch) = pk2(silu2(y.x, bflo(gc)), silu2(y.y, bfhi(gc)));
    LDS_WAIT(); __syncthreads();
}
#if USE_CHUNKED
__device__ __forceinline__ void p3_phase(const PArgs& a, LAS unsigned char* lds, int tid, int lane, int wave, int li) {
    constexpr int NIT = NB * NH * (SEQ / 64); const unsigned char* ws = A_WS;
    ChunkIn cur, nxt; int it = blockIdx.x;
    if (tid < 128) ((LAS float*)(lds + 15 * CMAT * 2 + 256))[512 + tid] = A_IN(I_MU)[3072 + tid];
    {
        const bf16* PS = (const bf16*)(A_WS + WS_PS); float* o_ = A_OUT + O_SHP;
        for (int i = blockIdx.x * NTHR + tid; i < NB * (SHW / 4); i += gridDim.x * NTHR) { const int b_ = i / (SHW / 4), c_ = i - b_ * (SHW / 4); const v2u x = *(const v2u*)(PS + ((size_t)b_ * SEQ + SEQ - 1) * PSW + 4 * c_);
            *(f32x4*)(o_ + (size_t)b_ * SHW + 4 * c_) = (f32x4){bflo(x.x), bfhi(x.x), bflo(x.y), bfhi(x.y)}; } }
    LoraW lw;
    if (it < NIT) { chunk_in_load(cur, a, it, tid); lora_load(lw, a, it, tid); }
    for (; it < NIT; it += gridDim.x) {
        const int itn = it + gridDim.x < NIT ? it + gridDim.x : it;
        chunk_in_load(nxt, a, itn, tid);
        chunk_pre(a, lds, tid, lane, wave, it, cur, PROBE_DUP == 3 && li == 1, lw, itn);
        cur = nxt;
    }
    __syncthreads();
}
__device__ __forceinline__ void p4_phase(const PArgs& a, LAS unsigned char* lds, int tid, int lane, int wave, int li) {
    const int G = gridDim.x, bid = blockIdx.x, ns = G > 64 ? 64 : G;
    const int pm = (PROBE_DUP == 4 && li == 1) ? (PROBE_P3MODE == 5 ? 1 : PROBE_P3MODE) : 0;
    if (bid < ns && (pm == 0 || pm == 1)) for (int bh = bid; bh < NB * NH; bh += ns) chunk_chain(a, lds, tid, lane, wave, bh, PROBE_P3MODE == 5 && PROBE_DUP == 4 && li == 1);
    if (pm == 0 || pm == 2) {
        if (G == 256) { const int ob_ = bid - 64; int i0_ = 0, n_ = 0;
            if (bid < 64) n_ = 0; else if (ob_ < 64) { i0_ = ob_; n_ = 1; } else if (ob_ < 128) { i0_ = 64 + 2 * (ob_ - 64); n_ = 2; } else { i0_ = 192 + (ob_ - 128); n_ = 1; }
            for (int q = 0; q < n_; ++q) conv_prompt_item(a, lds, tid, lane, wave, i0_ + q);
        } else for (int it = bid; it < 256; it += G) conv_prompt_item(a, lds, tid, lane, wave, it); }
    if (bid < ns && G > 64) { if ((pm == 0 || pm == 3) && G == 256) { LDS_WAIT(); __syncthreads(); conv_sample_one(a, (LAS float*)(lds + 90112), lane, wave, bid); } return; }
    if (!(pm == 0 || pm == 3)) return;
    const int ob = G > 64 ? bid - 64 : bid, on = G > 64 ? G - 64 : G;
    const int gwv = ob * NWAVES + wave, NGW = on * NWAVES;
    if (G == 256) { if (ob >= 128) conv_sample_one(a, (LAS float*)(lds + 90112), lane, wave, 64 + (ob - 128)); }
    else for (int it = on - 1 - ob; it < MS / 2; it += on) conv_sample_wg(a, (LAS float*)(lds + 90112), lane, wave, it);
    for (int it = gwv; it < MS * NH; it += NGW) sample_wkv_item(a, (LAS float*)(lds + 65536) + wave * 640, lane, it);
    {
        const bf16* PS = (const bf16*)(A_WS + WS_PS); float* o_ = A_OUT + O_SHS;
        for (int i = gwv * 64 + lane; i < MS * (SHW / 4); i += NGW * 64) { const int s_ = i / (SHW / 4), c_ = i - s_ * (SHW / 4); const v2u x = *(const v2u*)(PS + (size_t)(MP + s_) * PSW + 4 * c_);
            *(f32x4*)(o_ + (size_t)s_ * SHW + 4 * c_) = (f32x4){bflo(x.x), bfhi(x.x), bflo(x.y), bfhi(x.y)}; } }
    LDS_WAIT(); __syncthreads();
    if (pm == 0 && !(LATE_IN_P1 && G == 256)) late_weights(a, lds, lane, wave, 1, gwv, NGW);
}
#else
__device__ __forceinline__ void p3_phase(const PArgs& a, LAS unsigned char* lds, int tid, int lane, int wave, int li) {
    for (int it = blockIdx.x; it < NB * NH * 4; it += gridDim.x) scan_prompt(a, lds, tid, lane, wave, it);
}
__device__ __forceinline__ void p4_phase(const PArgs& a, LAS unsigned char* lds, int tid, int lane, int wave, int li) {
    const int G = gridDim.x, bid = blockIdx.x;
    const int gwv = bid * NWAVES + wave, NGW = G * NWAVES;
    for (int it = gwv; it < MS * NH; it += NGW) sample_wkv_item(a, (LAS float*)(lds + 65536) + wave * 640, lane, it);
    for (int it = bid; it < 256; it += G) conv_prompt_item(a, lds, tid, lane, wave, it);
    for (int it = G - 1 - bid; it < MS / 2; it += G) conv_sample_wg(a, (LAS float*)(lds + 90112), lane, wave, it);
    LDS_WAIT(); __syncthreads();
    late_weights(a, lds, lane, wave, 1, gwv, NGW);
}
#endif
__device__ __forceinline__ void p5_phase(const PArgs& a, int tid, int lane, int wave) {
    const int G = gridDim.x, bid = blockIdx.x;
    { unsigned char* ws = A_WS; GAS v4u* z1 = (GAS v4u*)(ws + WS_OA + (size_t)MV * OAS * 2);
      for (int i = bid * NTHR + tid; i < 128 * OAS * 2 / 16; i += G * NTHR) z1[i] = (v4u){0u, 0u, 0u, 0u}; }
    for (int m = bid * NWAVES + wave; m < MP; m += G * NWAVES) oa_token(a, lane, m);
}

__device__ __forceinline__ void thin_part(f32x4 (&acc)[4], const bf16* A, int lda, const bf16* Bt, int ldb, LAS unsigned char* wl, int lane) {
    const int lr = lane >> 3, lc = lane & 7, fr = lane & 15, fq = lane >> 4;
    const bf16* ag = A + (size_t)lr * lda + 8 * lc; const bf16* bg = Bt + (size_t)lr * ldb + 8 * lc;
    v4u ra[4][4], rb[4][4];
#pragma unroll
    for (int r = 0; r < 4; ++r) {
#pragma unroll
        for (int i = 0; i < 4; ++i) { ra[r][i] = *(const v4u*)(ag + (size_t)8 * i * lda + 64 * r); rb[r][i] = *(const v4u*)(bg + (size_t)8 * i * ldb + 64 * r); } }
    LAS unsigned char* wa = wl + lr * 144 + 16 * lc; const LAS unsigned char* fa = wl + fr * 144 + 16 * fq;
#pragma unroll
    for (int r = 0; r < 4; ++r) {
#pragma unroll
        for (int i = 0; i < 4; ++i) { *(LAS v4u*)(wa + 8 * i * 144) = ra[r][i]; *(LAS v4u*)(wa + 4608 + 8 * i * 144) = rb[r][i]; }
#pragma unroll
        for (int ks = 0; ks < 2; ++ks) {
            const bf16x8 a0 = *(const LAS bf16x8*)(fa + 64 * ks), a1 = *(const LAS bf16x8*)(fa + 16 * 144 + 64 * ks), b0 = *(const LAS bf16x8*)(fa + 4608 + 64 * ks), b1 = *(const LAS bf16x8*)(fa + 4608 + 16 * 144 + 64 * ks);
            acc[0] = __builtin_amdgcn_mfma_f32_16x16x32_bf16(a0, b0, acc[0], 0, 0, 0); acc[1] = __builtin_amdgcn_mfma_f32_16x16x32_bf16(a0, b1, acc[1], 0, 0, 0);
            acc[2] = __builtin_amdgcn_mfma_f32_16x16x32_bf16(a1, b0, acc[2], 0, 0, 0); acc[3] = __builtin_amdgcn_mfma_f32_16x16x32_bf16(a1, b1, acc[3], 0, 0, 0); }
    }
}
#define THIN_PUT(acc_) do { _Pragma("unroll") for (int tl_ = 0; tl_ < 4; ++tl_) xch[(wave * 4 + tl_) * 64 + lane] = acc_[tl_]; } while (0)
#define THIN_ITEM() const int c0 = ((j & 7) * 8 + (j >> 5)) * 32, rowbase = MP + ((j >> 3) & 3) * 32
#define THIN_MC() const size_t m = (size_t)rowbase + 16 * (wave >> 1) + 4 * fq + reg; const int col = c0 + 16 * (wave & 1) + fr
__device__ __forceinline__ void thin_g2(const PArgs& a, LAS unsigned char* lds, int lane, int wave) {
    unsigned char* ws = A_WS; const bf16* OA = (const bf16*)(ws + WS_OA); const bf16* WaT = (const bf16*)(ws + WS_WAT);
    const bf16* MG = (const bf16*)(ws + WS_MG); bf16* Mb = (bf16*)(ws + WS_MB);
    LAS f32x4* xch = (LAS f32x4*)(lds + 8 * 9216); const int fr = lane & 15, fq = lane >> 4;
    const f32x4 Z4 = {0.f, 0.f, 0.f, 0.f};
    for (int j = blockIdx.x; j < 256; j += gridDim.x) {
        THIN_ITEM();
        f32x4 acc[4] = {Z4, Z4, Z4, Z4};
        thin_part(acc, OA + (size_t)rowbase * OAS + 256 * wave, OAS, WaT + (size_t)c0 * OAS + 256 * wave, OAS, lds + wave * 9216, lane);
        THIN_PUT(acc);
        LDS_WAIT(); __syncthreads();
        if (wave < 4) { f32x4 ya = Z4, yb = Z4;
#pragma unroll
            for (int w = 0; w < 4; ++w) { ya += xch[(w * 4 + wave) * 64 + lane]; yb += xch[((w + 4) * 4 + wave) * 64 + lane]; }
#pragma unroll
            for (int reg = 0; reg < 4; ++reg) { THIN_MC();
                const float ga = bf1(MG[m * 4096 + col]), gb = bf1(MG[m * 4096 + 2048 + col]);
                Mb[m * DM + col] = (bf16)f2bf(sigm(ga) * ya[reg] + sigm(gb) * yb[reg]); } }
        LDS_WAIT(); __syncthreads();
    }
}
__device__ __forceinline__ void thin_g3(const PArgs& a, LAS unsigned char* lds, int lane, int wave) {
    unsigned char* ws = A_WS; const bf16* Mb = (const bf16*)(ws + WS_MB); const bf16* WoT = (const bf16*)(ws + WS_WOT); bf16* HB = (bf16*)(ws + WS_HB); const float* xs = A_IN(I_XS);
    LAS f32x4* xch = (LAS f32x4*)(lds + 8 * 9216); const int fr = lane & 15, fq = lane >> 4;
    const f32x4 Z4 = {0.f, 0.f, 0.f, 0.f};
    for (int j = blockIdx.x; j < 256; j += gridDim.x) {
        THIN_ITEM();
        f32x4 acc[4] = {Z4, Z4, Z4, Z4};
        thin_part(acc, Mb + (size_t)rowbase * DM + 256 * wave, DM, WoT + (size_t)c0 * DM + 256 * wave, DM, lds + wave * 9216, lane);
        THIN_PUT(acc);
        LDS_WAIT(); __syncthreads();
        if (wave < 4) { f32x4 y = Z4;
#pragma unroll
            for (int w = 0; w < 8; ++w) y += xch[(w * 4 + wave) * 64 + lane];
#pragma unroll
            for (int reg = 0; reg < 4; ++reg) { THIN_MC();
                HB[m * DM + col] = (bf16)f2bf(xs[(m - MP) * DM + col] + y[reg]); } }
        LDS_WAIT(); __syncthreads();
    }
}
__device__ __forceinline__ void thin_g4(const PArgs& a, LAS unsigned char* lds, int lane, int wave) {
    unsigned char* ws = A_WS; const bf16* HB = (const bf16*)(ws + WS_HB); const bf16* WgT = (const bf16*)(ws + WS_WGT); const bf16* PB = (const bf16*)(ws + WS_PB); const bf16* WpT = (const bf16*)(ws + WS_WPT); bf16* H2B = (bf16*)(ws + WS_H2B);
    LAS f32x4* xch = (LAS f32x4*)(lds + 8 * 9216); LAS f32x4* xch2 = xch + 8 * 4 * 64; const int fr = lane & 15, fq = lane >> 4;
    const f32x4 Z4 = {0.f, 0.f, 0.f, 0.f};
    for (int j = blockIdx.x; j < 256; j += gridDim.x) {
        THIN_ITEM();
        f32x4 acc[4] = {Z4, Z4, Z4, Z4}, ae[4];
        { const bf16* pa = PB + (size_t)(rowbase + fr) * PLE + 32 * wave + 8 * fq; const bf16* pb = WpT + (size_t)(c0 + fr) * PLE + 32 * wave + 8 * fq;
          const bf16x8 a0 = *(const bf16x8*)pa, a1 = *(const bf16x8*)(pa + 16 * PLE), b0 = *(const bf16x8*)pb, b1 = *(const bf16x8*)(pb + 16 * PLE);
          ae[0] = __builtin_amdgcn_mfma_f32_16x16x32_bf16(a0, b0, Z4, 0, 0, 0); ae[1] = __builtin_amdgcn_mfma_f32_16x16x32_bf16(a0, b1, Z4, 0, 0, 0);
          ae[2] = __builtin_amdgcn_mfma_f32_16x16x32_bf16(a1, b0, Z4, 0, 0, 0); ae[3] = __builtin_amdgcn_mfma_f32_16x16x32_bf16(a1, b1, Z4, 0, 0, 0); }
        thin_part(acc, HB + (size_t)rowbase * DM + 256 * wave, DM, WgT + (size_t)c0 * DM + 256 * wave, DM, lds + wave * 9216, lane);
        THIN_PUT(acc);
#pragma unroll
        for (int tl = 0; tl < 4; ++tl) xch2[(wave * 4 + tl) * 64 + lane] = ae[tl];
        LDS_WAIT(); __syncthreads();
        if (wave < 4) { f32x4 y = Z4, e = Z4;
#pragma unroll
            for (int w = 0; w < 8; ++w) { y += xch[(w * 4 + wave) * 64 + lane]; e += xch2[(w * 4 + wave) * 64 + lane]; }
#pragma unroll
            for (int reg = 0; reg < 4; ++reg) { THIN_MC();
                H2B[m * DM + col] = (bf16)f2bf(bf1(HB[m * DM + col]) + sigm(y[reg]) * e[reg]); } }
        LDS_WAIT(); __syncthreads();
    }
}
#undef THIN_PUT
#undef THIN_ITEM
#undef THIN_MC

__device__ __forceinline__ void final_norm(const PArgs& a, int lane, int wave, int vcu, int G, int mbeg = 0) {
    const int gw = vcu * NWAVES + wave, NGW = G * NWAVES; const float* fg = A_IN(I_FING); const bf16* H2B = (const bf16*)(A_WS + WS_H2B); float* out = A_OUT;
    for (int m = mbeg + gw; m < MV; m += NGW) {
        const GAS v4u* hr = (const GAS v4u*)(H2B + (size_t)m * DM) + lane;
        f32x4 v[8]; float s = 0.f;
#pragma unroll
        for (int j = 0; j < 4; ++j) { const v4u h = hr[64 * j];
            v[2 * j] = (f32x4){bflo(h.x), bfhi(h.x), bflo(h.y), bfhi(h.y)}; v[2 * j + 1] = (f32x4){bflo(h.z), bfhi(h.z), bflo(h.w), bfhi(h.w)};
            s += (v[2 * j].x * v[2 * j].x + v[2 * j].y * v[2 * j].y) + (v[2 * j].z * v[2 * j].z + v[2 * j].w * v[2 * j].w) + (v[2 * j + 1].x * v[2 * j + 1].x + v[2 * j + 1].y * v[2 * j + 1].y) + (v[2 * j + 1].z * v[2 * j + 1].z + v[2 * j + 1].w * v[2 * j + 1].w); }
        const float rs = 1.0f / sqrtf(wave_sum(s) * (1.0f / DM) + RMS_EPS);
        GAS f32x4* orow = (GAS f32x4*)(out + (size_t)m * DM);
#pragma unroll
        for (int j = 0; j < 4; ++j) { const int c4 = 2 * (lane + 64 * j);
            orow[c4] = v[2 * j] * rs * ((const GAS f32x4*)fg)[c4]; orow[c4 + 1] = v[2 * j + 1] * rs * ((const GAS f32x4*)fg)[c4 + 1]; }
    }
}

namespace pg8 {
struct EpiPleNorm {
    static constexpr bool PERM = true, AFTER_DRAIN = true, HAS_MID = false;
    const bf16_t* HB; const bf16_t* E; float* rowsq; const float* fg; float* out; XcdBarrier bar;
    __device__ __forceinline__ void fused(f32x4 (&acc)[2][2][4][2], const Unit& u, int wr, int wc, int, int, LAS unsigned char* lds, int, int) const {
        int t = threadIdx.x; asm volatile("" : "+v"(t)); const int lane = t & 63, fr = lane & 15, fq = lane >> 4;
        int row0 = u.pm * BM + wr * 64 + fr; const int col0 = u.pn * BM + wc * 32 + 8 * fq;
        asm volatile("" : "+v"(row0));
        LAS float* rs_l = (LAS float*)lds;
#pragma unroll
        for (int ai = 0; ai < 2; ++ai)
#pragma unroll
            for (int m = 0; m < 4; ++m) { const size_t row = (size_t)(row0 + ai * HALF + m * 16); float ss = 0.f;
#pragma unroll
                for (int bj = 0; bj < 2; ++bj) { const int col = col0 + bj * HALF; const u32x4 e = *(const u32x4*)(E + row * 2048 + col), h = *(const u32x4*)(HB + row * 2048 + col);
                    const f32x4 v0 = acc[ai][bj][m][0], v1 = acc[ai][bj][m][1];
                    f32x4 h0, h1;
                    h0[0] = bflo(h.x) + sigm(v0[0]) * bflo(e.x); h0[1] = bfhi(h.x) + sigm(v0[1]) * bfhi(e.x); h0[2] = bflo(h.y) + sigm(v0[2]) * bflo(e.y); h0[3] = bfhi(h.y) + sigm(v0[3]) * bfhi(e.y);
                    h1[0] = bflo(h.z) + sigm(v1[0]) * bflo(e.z); h1[1] = bfhi(h.z) + sigm(v1[1]) * bfhi(e.z); h1[2] = bflo(h.w) + sigm(v1[2]) * bflo(e.w); h1[3] = bfhi(h.w) + sigm(v1[3]) * bfhi(e.w);
                    acc[ai][bj][m][0] = h0; acc[ai][bj][m][1] = h1;
                    ss += ((h0[0] * h0[0] + h0[1] * h0[1]) + (h0[2] * h0[2] + h0[3] * h0[3])) + ((h1[0] * h1[0] + h1[1] * h1[1]) + (h1[2] * h1[2] + h1[3] * h1[3])); }
                ss += __shfl_xor(ss, 16); ss += __shfl_xor(ss, 32);
                if (fq == 0) rs_l[wc * 256 + wr * 64 + ai * HALF + m * 16 + fr] = ss;
                asm volatile("" ::: "memory"); }
        LDS_WAIT(); __syncthreads();
        if (t < 256) (void)__hip_atomic_fetch_add(rowsq + u.pm * BM + t, (rs_l[t] + rs_l[256 + t]) + (rs_l[512 + t] + rs_l[768 + t]), __ATOMIC_RELAXED, __HIP_MEMORY_SCOPE_AGENT);
        xcd_barrier(bar);
#pragma unroll
        for (int ai = 0; ai < 2; ++ai)
#pragma unroll
            for (int m = 0; m < 4; ++m) { const size_t row = (size_t)(row0 + ai * HALF + m * 16);
                const float rs = __builtin_amdgcn_rsqf(rowsq[row] * (1.0f / 2048.0f) + 1e-6f);
#pragma unroll
                for (int bj = 0; bj < 2; ++bj) { const int col = col0 + bj * HALF; const f32x4 g0 = *(const f32x4*)(fg + col), g1 = *(const f32x4*)(fg + col + 4);
                    *(f32x4*)(out + row * 2048 + col) = acc[ai][bj][m][0] * rs * g0; *(f32x4*)(out + row * 2048 + col + 4) = acc[ai][bj][m][1] * rs * g1; }
                asm volatile("" ::: "memory"); }
    }
};
}

__global__ void __launch_bounds__(NTHR, 2) hybrid_fwd(Args args) {
    extern __shared__ __attribute__((aligned(16))) unsigned char lds_raw[];
    LAS unsigned char* lds = (LAS unsigned char*)lds_raw;
    volatile LAS unsigned* MISC = (volatile LAS unsigned*)(lds + MISC_OFF);
    const int G = gridDim.x; const int bx = blockIdx.x; const int vcu = (G % 8 == 0) ? (bx % 8) * (G / 8) + bx / 8 : bx;
    {
        const int tid0 = opaque_tid();
        for (int u = tid0; u < (LDS_BYTES - LDSCTL_OFF) / 4; u += NTHR) ((LAS unsigned*)(lds + LDSCTL_OFF))[u] = 0u;
        __syncthreads();
        if (tid0 < 31) { const unsigned long long p = tid0 < 29 ? (unsigned long long)args.in[tid0] : (tid0 == 29 ? (unsigned long long)args.out : (unsigned long long)args.ws);
            *(LAS v2u*)(lds + LDSCTL_OFF + 8 * tid0) = (v2u){(unsigned)p, (unsigned)(p >> 32)}; }
        LDS_WAIT(); __syncthreads();
    }
    const PArgs a{lds};
    XcdBarrier bar; bar.bar = nullptr; bar.x = 0; bar.st = nullptr;
    if (N_LAUNCHES != PER_PHASE) bar = xcd_barrier_post((unsigned*)(A_WS + WS_CTL) + CW_BAR + args.li * XCD_BAR_WORDS, MISC + 8);
    const int lo = args.ph_lo, hi = args.ph_hi;
#define IN(k) (lo <= (k) && (k) < hi)
#define SEAM(k) do { if (IN(k) && IN((k) + 1)) xcd_barrier(bar); } while (0)
    using namespace pg8;
    if (IN(0)) { const int t = opaque_tid(); p0_prologue(a, lds, t & 63, __builtin_amdgcn_readfirstlane(t >> 6), vcu, G); SEAM(0); }
    if (IN(1)) {
        unsigned char* ws = A_WS;
        Gemm g{(const bf16_t*)(ws + WS_XN), (const bf16_t*)(ws + WS_WTIN), MPAD, N1, DM}; StaticOrder S; S.init(MPAD, N1, G, bx);
        EpiProj E{(bf16_t*)(ws + WS_PS), (bf16_t*)(ws + WS_GA), (bf16_t*)(ws + WS_GLU), (bf16_t*)(ws + WS_GB), (bf16_t*)(ws + WS_MG)};
        gemm_phase<EpiProj, StaticOrder, true, true>(lds, g, S, E);
        {
            const int nun = (MPAD / 256) * (N1 / 256), full = nun % G;
            if (full != 0 && bx >= full) { __syncthreads(); const int t = opaque_tid(); late_weights(a, lds, t & 63, __builtin_amdgcn_readfirstlane(t >> 6), 0, (bx - full) * NWAVES + (t >> 6), (G - full) * NWAVES);
                if (LATE_IN_P1) late_weights(a, lds, t & 63, __builtin_amdgcn_readfirstlane(t >> 6), 1, (bx - full) * NWAVES + (t >> 6), (G - full) * NWAVES); }
            else if (full == 0) { __syncthreads(); const int t = opaque_tid(); late_weights(a, lds, t & 63, __builtin_amdgcn_readfirstlane(t >> 6), 0, bx * NWAVES + (t >> 6), G * NWAVES); }
        }
        SEAM(1);
    }
    if (IN(3)) { const int t = opaque_tid(); p3_phase(a, lds, t, t & 63, __builtin_amdgcn_readfirstlane(t >> 6), args.li); SEAM(3); }
    if (IN(4)) { const int t = opaque_tid(); p4_phase(a, lds, t, t & 63, __builtin_amdgcn_readfirstlane(t >> 6), args.li); SEAM(4); }
    if (IN(5)) { const int t = opaque_tid(); p5_phase(a, t, t & 63, __builtin_amdgcn_readfirstlane(t >> 6)); SEAM(5); }
    if (IN(6)) {
        unsigned char* ws = A_WS;
        StaticOrder S; S.init(MP, DM, G, bx);
        { Gemm g{(const bf16_t*)(ws + WS_OA), (const bf16_t*)(ws + WS_WAT), MP, DM, 2 * DA}; EpiGate E{(const bf16_t*)(ws + WS_MG), (bf16_t*)(ws + WS_MB)};
          gemm_phase<EpiGate, StaticOrder, true, true>(lds, g, S, E); }
        __syncthreads();
        { const int t = opaque_tid(); thin_g2(a, lds, t & 63, __builtin_amdgcn_readfirstlane(t >> 6)); }
        SEAM(6);
    }
    if (IN(7)) {
        unsigned char* ws = A_WS;
        { StaticOrder S; S.init(MP, DM, G, bx); Gemm g{(const bf16_t*)(ws + WS_MB), (const bf16_t*)(ws + WS_WOT), MP, DM, DM};
          EpiRes E{A_IN(I_XP), A_IN(I_XS), (bf16_t*)(ws + WS_HB)};
          gemm_phase<EpiRes, StaticOrder, true, true>(lds, g, S, E); }
        __syncthreads();
        { StaticOrder S; S.init(MP, DM, G, G - 1 - bx); Gemm g{(const bf16_t*)(ws + WS_PB), (const bf16_t*)(ws + WS_WPT), MP, DM, PLE};
          EpiStoreBf16 E{(bf16_t*)(ws + WS_E), DM};
          gemm_phase<EpiStoreBf16, StaticOrder, true, true>(lds, g, S, E); }
        __syncthreads();
        { const int t = opaque_tid(); thin_g3(a, lds, t & 63, __builtin_amdgcn_readfirstlane(t >> 6)); }
        SEAM(7);
    }
    if (IN(8)) {
        unsigned char* ws = A_WS;
        StaticOrder S; S.init(MP, DM, G, bx); Gemm g{(const bf16_t*)(ws + WS_HB), (const bf16_t*)(ws + WS_WGT), MP, DM, DM};
        if (FUSE_NORM && G == 256 && IN(9)) {
            { const int t = opaque_tid(); thin_g4(a, lds, t & 63, __builtin_amdgcn_readfirstlane(t >> 6)); }
            __syncthreads();
            EpiPleNorm E{(const bf16_t*)(ws + WS_HB), (const bf16_t*)(ws + WS_E), (float*)(ws + WS_CTL) + CW_ROWSQ, A_IN(I_FING), A_OUT, bar};
            gemm_phase<EpiPleNorm, StaticOrder, true, true>(lds, g, S, E);
            { const int t = opaque_tid(); final_norm(a, t & 63, __builtin_amdgcn_readfirstlane(t >> 6), vcu, G, MP); }
        } else {
            EpiPle E{(const bf16_t*)(ws + WS_HB), (const bf16_t*)(ws + WS_E), (bf16_t*)(ws + WS_H2B)};
            gemm_phase<EpiPle, StaticOrder, true, true>(lds, g, S, E);
            __syncthreads();
            { const int t = opaque_tid(); thin_g4(a, lds, t & 63, __builtin_amdgcn_readfirstlane(t >> 6)); }
            SEAM(8);
        }
    }
    if (IN(9) && !(FUSE_NORM && G == 256 && IN(8))) { const int t = opaque_tid(); final_norm(a, t & 63, __builtin_amdgcn_readfirstlane(t >> 6), vcu, G); }
#undef IN
#undef SEAM
}

extern "C" void kernel_launch(void* const* d_in, const int* in_sizes, int n_in, void* d_out, int out_size, void* d_ws, size_t ws_size, hipStream_t stream) {
    static int grid = 0;
    if (grid == 0) {
        if (n_in != 29 || out_size != (int)O_END || ws_size < WS_END) { fprintf(stderr, "kernel_launch: built for 29 inputs, %zu outputs, >= %zu bytes of workspace; got n_in %d, out %d, ws %zu; nothing launched\n", (size_t)O_END, (size_t)WS_END, n_in, out_size, ws_size); grid = -1; return; }
        int dev = 0, cus = 0, per_cu = 0;
        if (hipGetDevice(&dev) != hipSuccess || hipDeviceGetAttribute(&cus, hipDeviceAttributeMultiprocessorCount, dev) != hipSuccess) { fprintf(stderr, "kernel_launch: device query failed\n"); grid = -1; return; }
        if (hipFuncSetAttribute((const void*)hybrid_fwd, hipFuncAttributeMaxDynamicSharedMemorySize, LDS_BYTES) != hipSuccess) { fprintf(stderr, "kernel_launch: hipFuncSetAttribute failed\n"); grid = -1; return; }
        if (hipOccupancyMaxActiveBlocksPerMultiprocessor(&per_cu, (const void*)hybrid_fwd, NTHR, LDS_BYTES) != hipSuccess || per_cu < 1)
            fprintf(stderr, "kernel_launch: note: occupancy query reports %d workgroups per CU\n", per_cu);
        (void)hipGetLastError();
        grid = cus;
    }
    if (grid < 0) return;
    if (hipMemsetAsync((char*)d_ws + WS_CTL, 0, CTL_ZERO_BYTES, stream) != hipSuccess) { fprintf(stderr, "kernel_launch: hipMemsetAsync failed\n"); return; }
    Args a{};
    for (int i = 0; i < 29; ++i) a.in[i] = (const float*)d_in[i];
    a.out = (float*)d_out; a.ws = (unsigned char*)d_ws;
    const int nl = (PROBE_DUP >= 0) ? 2 : N_LAUNCHES;
    for (int li = 0; li < nl; ++li) {
        a.ph_lo = (N_LAUNCHES == PER_PHASE) ? li : 0; a.ph_hi = (N_LAUNCHES == PER_PHASE) ? li + 1 : PER_PHASE; a.li = li;
        if (PROBE_DUP >= 0) { a.ph_lo = li == 0 ? 0 : (PROBE_DUP == 8 ? 7 : PROBE_DUP); a.ph_hi = li == 0 ? PROBE_DUP + 1 : PER_PHASE; }
        hipLaunchKernelGGL(hybrid_fwd, dim3(grid), dim3(NTHR), LDS_BYTES, stream, a);
        const hipError_t le = hipPeekAtLastError();
        if (le != hipSuccess) { fprintf(stderr, "kernel_launch: launch %d failed: %s\n", li, hipGetErrorName(le)); break; }
    }
}
```

```cpp
#include <hip/hip_runtime.h>
#include <cstdio>
#include <cstdint>
namespace pg8 {
#define PG8_LAS __attribute__((address_space(3)))
typedef unsigned short bf16_t;
typedef short bf16x8 __attribute__((ext_vector_type(8)));
typedef float f32x4 __attribute__((ext_vector_type(4)));
typedef unsigned u32x4 __attribute__((ext_vector_type(4)));
constexpr int BM = 256, BK = 64, HALF = 128, HTB = HALF * BK * 2  , STAGE_BYTES = 8 * HTB, NXCD = 8, WGM = 8;

__host__ __device__ __forceinline__ int lds_byte(int r, int c) { const int st = (r >> 4) * 2 + (c >> 5), rr = r & 15, cc = c & 31, ob = rr * 64 + cc * 2; return st * 1024 + (ob ^ (((ob >> 9) & 1) << 5)); }
__host__ __device__ __forceinline__ void stage_rc(int b, int& R, int& C) { const int st = b / 1024, sb = b % 1024, swz = sb ^ (((sb >> 9) & 1) << 5); R = (st >> 1) * 16 + swz / 64; C = (st & 1) * 32 + (swz % 64) / 2; }
__host__ __device__ __forceinline__ int perm32(int rho) { const int n = rho >> 4, i = rho & 15; return 8 * (i >> 2) + 4 * n + (i & 3); }

struct Unit { int pm, pn; };
struct Gemm { const bf16_t* A; const bf16_t* Bt; int M, N, K; };

struct StaticOrder {
    int nM, nN, nwg, G, c, wgm = WGM;
    __host__ __device__ void init(int M, int N, int G_, int c_) { nM = M / BM; nN = N / BM; nwg = nM * nN; G = G_; c = c_; }
    __host__ __device__ bool next(int i, Unit& u) const {
        const long L = (long)i * G + c; if (L >= nwg) return false;
        int wgid = (int)L; { const int q = nwg / NXCD, r = nwg % NXCD, xcd = wgid % NXCD, off = wgid / NXCD; wgid = (xcd < r ? xcd * (q + 1) : r * (q + 1) + (xcd - r) * q) + off; }
        const int nig = wgm * nN, gid = wgid / nig, fm = gid * wgm, gsz = (nM - fm) < wgm ? (nM - fm) : wgm;
        u.pm = fm + ((wgid % nig) % gsz); u.pn = (wgid % nig) / gsz; return true;
    }
    __device__ __forceinline__ void a_ready(const Unit&) const {}
    __device__ __forceinline__ void done(const Unit&) const {}
};


__device__ __forceinline__ unsigned cvt_pk_bf16(float lo, float hi) { unsigned r; asm volatile("v_cvt_pk_bf16_f32 %0, %1, %2" : "=v"(r) : "v"(lo), "v"(hi)); return r; }
__device__ __forceinline__ float bflo(unsigned u) { return __uint_as_float(u << 16); }
__device__ __forceinline__ float bfhi(unsigned u) { return __uint_as_float(u & 0xffff0000u); }
__device__ __forceinline__ float sigm(float x) { return __builtin_amdgcn_rcpf(1.0f + __expf(-x)); }
constexpr int E_MV = 8320;

struct EpiProj {
    static constexpr bool PERM = true, AFTER_DRAIN = false, HAS_MID = false;
    bf16_t *PS, *GA, *GLU, *GB, *MG;
    __device__ __forceinline__ void operator()(const f32x4 (&acc)[2][2][4][2], const Unit& u, int wr, int wc, int fr, int fq) const {
        bf16_t* base; int ldc, ct; const int pn = u.pn;
        if (pn < 13) { base = PS; ldc = 3328; ct = pn; } else if (pn < 17) { base = GA; ldc = 1024; ct = pn - 13; } else if (pn < 25) { base = GLU; ldc = 2048; ct = pn - 17; }
        else if (pn < 29) { base = GB; ldc = 1024; ct = pn - 25; } else { base = MG; ldc = 4096; ct = pn - 29; }
        int row0 = u.pm * BM + wr * 64 + fr; const int col0 = ct * BM + wc * 32 + 8 * fq; const bool glu = pn >= 17 && pn < 25;
        asm volatile("" : "+v"(row0));
#pragma unroll
        for (int ai = 0; ai < 2; ++ai)
#pragma unroll
            for (int m = 0; m < 4; ++m) {
                if (glu) { bf16_t* rowp = GLU + (size_t)(row0 + ai * HALF + m * 16) * 1024 + ct * HALF + wc * 32 + 8 * fq;
                    const f32x4 v0 = acc[ai][0][m][0], v1 = acc[ai][0][m][1], g0 = acc[ai][1][m][0], g1 = acc[ai][1][m][1];
                    u32x4 w; w.x = cvt_pk_bf16(v0[0] * sigm(g0[0]), v0[1] * sigm(g0[1])); w.y = cvt_pk_bf16(v0[2] * sigm(g0[2]), v0[3] * sigm(g0[3]));
                    w.z = cvt_pk_bf16(v1[0] * sigm(g1[0]), v1[1] * sigm(g1[1])); w.w = cvt_pk_bf16(v1[2] * sigm(g1[2]), v1[3] * sigm(g1[3]));
                    *(u32x4*)rowp = w;
                } else { bf16_t* rowp = base + (size_t)(row0 + ai * HALF + m * 16) * ldc + col0;
#pragma unroll
                    for (int bj = 0; bj < 2; ++bj) { const f32x4 v0 = acc[ai][bj][m][0], v1 = acc[ai][bj][m][1];
                        u32x4 w; w.x = cvt_pk_bf16(v0[0], v0[1]); w.y = cvt_pk_bf16(v0[2], v0[3]); w.z = cvt_pk_bf16(v1[0], v1[1]); w.w = cvt_pk_bf16(v1[2], v1[3]);
                        *(u32x4*)(rowp + bj * HALF) = w; } }
                asm volatile("" ::: "memory"); }
    }
};
struct EpiStoreBf16 {
    static constexpr bool PERM = true, AFTER_DRAIN = false, HAS_MID = false;
    bf16_t* O; int ldc;
    __device__ __forceinline__ void operator()(const f32x4 (&acc)[2][2][4][2], const Unit& u, int wr, int wc, int fr, int fq) const {
        const int row0 = u.pm * BM + wr * 64 + fr, col0 = u.pn * BM + wc * 32 + 8 * fq;
#pragma unroll
        for (int ai = 0; ai < 2; ++ai)
#pragma unroll
            for (int m = 0; m < 4; ++m) { bf16_t* rowp = O + (size_t)(row0 + ai * HALF + m * 16) * ldc + col0;
#pragma unroll
                for (int bj = 0; bj < 2; ++bj) { const f32x4 v0 = acc[ai][bj][m][0], v1 = acc[ai][bj][m][1];
                    u32x4 w; w.x = cvt_pk_bf16(v0[0], v0[1]); w.y = cvt_pk_bf16(v0[2], v0[3]); w.z = cvt_pk_bf16(v1[0], v1[1]); w.w = cvt_pk_bf16(v1[2], v1[3]);
                    *(u32x4*)(rowp + bj * HALF) = w; } }
    }
};
struct EpiGate {
    static constexpr bool PERM = true, AFTER_DRAIN = false, HAS_MID = true;
    const bf16_t* MG; bf16_t* Mb;
    __device__ __forceinline__ void mid(f32x4 (&acc)[2][2][4][2], const Unit& u, int wr, int wc, int fr, int fq) const {
        int row0 = u.pm * BM + wr * 64 + fr, col0 = u.pn * BM + wc * 32 + 8 * fq;
        asm volatile("" : "+v"(row0), "+v"(col0));
        u32x4 ga[2][2], gb[2][2];
#define EG_LOAD(g_) do { const size_t o_ = (size_t)(row0 + ((g_) >> 2) * HALF + ((g_) & 3) * 16) * 4096 + col0; \
            ga[(g_) & 1][0] = *(const u32x4*)(MG + o_); ga[(g_) & 1][1] = *(const u32x4*)(MG + o_ + HALF); gb[(g_) & 1][0] = *(const u32x4*)(MG + o_ + 2048); gb[(g_) & 1][1] = *(const u32x4*)(MG + o_ + 2048 + HALF); } while (0)
#define EG_F(a_, b_) (sigm(a_) * (1.0f + __expf(-(b_))))
        EG_LOAD(0);
#pragma unroll
        for (int g = 0; g < 8; ++g) { const int ai = g >> 2, m = g & 3;
            if (g + 1 < 8) EG_LOAD(g + 1);
            asm volatile("" ::: "memory");
#pragma unroll
            for (int bj = 0; bj < 2; ++bj) { const u32x4 a_ = ga[g & 1][bj], b_ = gb[g & 1][bj];
                acc[ai][bj][m][0][0] *= EG_F(bflo(a_.x), bflo(b_.x)); acc[ai][bj][m][0][1] *= EG_F(bfhi(a_.x), bfhi(b_.x)); acc[ai][bj][m][0][2] *= EG_F(bflo(a_.y), bflo(b_.y)); acc[ai][bj][m][0][3] *= EG_F(bfhi(a_.y), bfhi(b_.y));
                acc[ai][bj][m][1][0] *= EG_F(bflo(a_.z), bflo(b_.z)); acc[ai][bj][m][1][1] *= EG_F(bfhi(a_.z), bfhi(b_.z)); acc[ai][bj][m][1][2] *= EG_F(bflo(a_.w), bflo(b_.w)); acc[ai][bj][m][1][3] *= EG_F(bfhi(a_.w), bfhi(b_.w)); }
        }
#undef EG_F
#undef EG_LOAD
    }
    __device__ __forceinline__ void operator()(const f32x4 (&acc)[2][2][4][2], const Unit& u, int wr, int wc, int fr, int fq) const {
        int row0 = u.pm * BM + wr * 64 + fr; const int col0 = u.pn * BM + wc * 32 + 8 * fq;
        asm volatile("" : "+v"(row0));
        u32x4 gq[2][2];
#define EG_LOAD(g_) do { const size_t o_ = (size_t)(row0 + ((g_) >> 2) * HALF + ((g_) & 3) * 16) * 4096 + 2048 + col0; gq[(g_) & 1][0] = *(const u32x4*)(MG + o_); gq[(g_) & 1][1] = *(const u32x4*)(MG + o_ + HALF); } while (0)
        EG_LOAD(0);
#pragma unroll
        for (int gi = 0; gi < 8; ++gi) { const int ai = gi >> 2, m = gi & 3; const size_t row = (size_t)(row0 + ai * HALF + m * 16);
            if (gi + 1 < 8) EG_LOAD(gi + 1);
            asm volatile("" ::: "memory");
#pragma unroll
            for (int bj = 0; bj < 2; ++bj) { const int col = col0 + bj * HALF; const u32x4 g = gq[gi & 1][bj];
                f32x4 v0 = acc[ai][bj][m][0], v1 = acc[ai][bj][m][1];
                v0[0] *= sigm(bflo(g.x)); v0[1] *= sigm(bfhi(g.x)); v0[2] *= sigm(bflo(g.y)); v0[3] *= sigm(bfhi(g.y));
                v1[0] *= sigm(bflo(g.z)); v1[1] *= sigm(bfhi(g.z)); v1[2] *= sigm(bflo(g.w)); v1[3] *= sigm(bfhi(g.w));
                u32x4 w; w.x = cvt_pk_bf16(v0[0], v0[1]); w.y = cvt_pk_bf16(v0[2], v0[3]); w.z = cvt_pk_bf16(v1[0], v1[1]); w.w = cvt_pk_bf16(v1[2], v1[3]);
                *(u32x4*)(Mb + row * 2048 + col) = w; }
        }
#undef EG_LOAD
    }
};
struct EpiRes {
    static constexpr bool PERM = true, AFTER_DRAIN = false, HAS_MID = false;
    const float* xp; const float* xs; bf16_t* HB;
    __device__ __forceinline__ void operator()(const f32x4 (&acc)[2][2][4][2], const Unit& u, int wr, int wc, int fr, int fq) const {
        const int row0 = u.pm * BM + wr * 64 + fr, col0 = u.pn * BM + wc * 32 + 8 * fq;
#pragma unroll
        for (int ai = 0; ai < 2; ++ai)
#pragma unroll
            for (int m = 0; m < 4; ++m) { const int r = row0 + ai * HALF + m * 16; const size_t row = (size_t)r; const bool valid = r < E_MV;
                const float* xr = r < 8192 ? xp + row * 2048 : xs + (size_t)(r - 8192) * 2048;
#pragma unroll
                for (int bj = 0; bj < 2; ++bj) { const int col = col0 + bj * HALF;
                    f32x4 v0 = acc[ai][bj][m][0], v1 = acc[ai][bj][m][1];
                    if (valid) { v0 += *(const f32x4*)(xr + col); v1 += *(const f32x4*)(xr + col + 4); }
                    u32x4 w; w.x = cvt_pk_bf16(v0[0], v0[1]); w.y = cvt_pk_bf16(v0[2], v0[3]); w.z = cvt_pk_bf16(v1[0], v1[1]); w.w = cvt_pk_bf16(v1[2], v1[3]);
                    *(u32x4*)(HB + row * 2048 + col) = w; }
                asm volatile("" ::: "memory"); }
    }
};
struct EpiPle {
    static constexpr bool PERM = true, AFTER_DRAIN = false, HAS_MID = false;
    const bf16_t* HB; const bf16_t* E; bf16_t* H2B;
    __device__ __forceinline__ void operator()(const f32x4 (&acc)[2][2][4][2], const Unit& u, int wr, int wc, int fr, int fq) const {
        const int row0 = u.pm * BM + wr * 64 + fr, col0 = u.pn * BM + wc * 32 + 8 * fq;
#pragma unroll
        for (int ai = 0; ai < 2; ++ai)
#pragma unroll
            for (int m = 0; m < 4; ++m) { const int r = row0 + ai * HALF + m * 16; const size_t row = (size_t)r;
                if (r < E_MV) {
#pragma unroll
                for (int bj = 0; bj < 2; ++bj) { const int col = col0 + bj * HALF; const u32x4 e = *(const u32x4*)(E + row * 2048 + col), h = *(const u32x4*)(HB + row * 2048 + col);
                    const f32x4 v0 = acc[ai][bj][m][0], v1 = acc[ai][bj][m][1];
                    f32x4 h0, h1;
                    h0[0] = bflo(h.x) + sigm(v0[0]) * bflo(e.x); h0[1] = bfhi(h.x) + sigm(v0[1]) * bfhi(e.x); h0[2] = bflo(h.y) + sigm(v0[2]) * bflo(e.y); h0[3] = bfhi(h.y) + sigm(v0[3]) * bfhi(e.y);
                    h1[0] = bflo(h.z) + sigm(v1[0]) * bflo(e.z); h1[1] = bfhi(h.z) + sigm(v1[1]) * bfhi(e.z); h1[2] = bflo(h.w) + sigm(v1[2]) * bflo(e.w); h1[3] = bfhi(h.w) + sigm(v1[3]) * bfhi(e.w);
                    u32x4 w; w.x = cvt_pk_bf16(h0[0], h0[1]); w.y = cvt_pk_bf16(h0[2], h0[3]); w.z = cvt_pk_bf16(h1[0], h1[1]); w.w = cvt_pk_bf16(h1[2], h1[3]);
                    *(u32x4*)(H2B + row * 2048 + col) = w; } }
                asm volatile("" ::: "memory"); }
    }
};

template <class Epi, class Sched, bool ALIGN_EPI = false, bool SP2 = false>
__device__ __forceinline__ void gemm_phase(PG8_LAS unsigned char* lds, const Gemm g, const Sched& S, const Epi& E) {
    int tid_ = threadIdx.x; asm volatile("" : "+v"(tid_));
    const int tid = tid_, wid = __builtin_amdgcn_readfirstlane(tid >> 6), lane = tid & 63, wr = wid >> 2, wc = wid & 3, fr = lane & 15, fq = lane >> 4;
    const int K = g.K, nt = K / BK;
    unsigned voffA[2], voffB[2];
#pragma unroll
    for (int i = 0; i < 2; ++i) { int R, C; stage_rc(tid * 16 + i * 8192, R, C); const int Rb = Epi::PERM ? ((R & ~31) + perm32(R & 31)) : R;
        voffA[i] = (unsigned)(R * K + C) * 2u; voffB[i] = (unsigned)(Rb * K + C) * 2u; }
    const size_t kstep = (size_t)(BK * 2);
    const size_t hstep = (size_t)HALF * K * 2;
    const size_t tstep = 2 * hstep;
    const unsigned ldsw = (unsigned)wid * 1024u;
    const int aoff = lds_byte(wr * 64 + fr, fq * 8), boff = lds_byte(wc * 32 + fr, fq * 8);
#define PG8_SA(b, h) (((b) * 2 + (h)) * HTB)
#define PG8_SB(b, h) ((4 + (b) * 2 + (h)) * HTB)
#define PG8_STAGE(bufoff, gbase, voff) do { _Pragma("unroll") for (int _i = 0; _i < 2; ++_i) \
        __builtin_amdgcn_global_load_lds((const unsigned*)((const char*)(gbase) + (voff)[_i]), (PG8_LAS unsigned*)(lds + (bufoff) + ldsw + _i * 8192), 16, 0, 0); } while (0)
#define PG8_LDA(dst, b, h) do { _Pragma("unroll") for (int m = 0; m < 4; ++m) _Pragma("unroll") for (int k = 0; k < 2; ++k) dst[m][k] = *(const PG8_LAS bf16x8*)(lds + PG8_SA(b, h) + aoff + m * 2048 + k * 1024); } while (0)
#define PG8_LDB(dst, b, h) do { _Pragma("unroll") for (int n = 0; n < 2; ++n) _Pragma("unroll") for (int k = 0; k < 2; ++k) dst[n][k] = *(const PG8_LAS bf16x8*)(lds + PG8_SB(b, h) + boff + n * 2048 + k * 1024); } while (0)
#define PG8_MMA(ai, bj, At, Bt) do { __builtin_amdgcn_s_setprio(1); _Pragma("unroll") for (int m = 0; m < 4; ++m) _Pragma("unroll") for (int n = 0; n < 2; ++n) _Pragma("unroll") for (int k = 0; k < 2; ++k) \
        acc[ai][bj][m][n] = __builtin_amdgcn_mfma_f32_16x16x32_bf16(Bt[n][k], At[m][k], acc[ai][bj][m][n], 0, 0, 0); __builtin_amdgcn_s_setprio(0); } while (0)
#define PG8_WAIT_V(n) asm volatile("s_waitcnt vmcnt(" #n ")" ::: "memory")
#define PG8_WAIT_L(n) asm volatile("s_waitcnt lgkmcnt(" #n ")" ::: "memory")
#define PG8_BAR __builtin_amdgcn_s_barrier()
#define PG8_SCHED __builtin_amdgcn_sched_barrier(0)
    Unit cur, nxt; int ui = 0;
    if (!S.next(0, cur)) return;
    f32x4 acc[2][2][4][2];
#pragma unroll
    for (int a = 0; a < 2; ++a)
#pragma unroll
        for (int b = 0; b < 2; ++b)
#pragma unroll
            for (int m = 0; m < 4; ++m)
#pragma unroll
                for (int n = 0; n < 2; ++n) acc[a][b][m][n] = (f32x4){0.f, 0.f, 0.f, 0.f};
    bf16x8 At[4][2], B0[2][2], B1[2][2];
    const char* cA = (const char*)g.A + (size_t)cur.pm * tstep; const char* cB = (const char*)g.Bt + (size_t)cur.pn * tstep;
    S.a_ready(cur);
    if constexpr (SP2) {
        PG8_STAGE(PG8_SB(0, 0), cB, voffB); PG8_STAGE(PG8_SB(0, 1), cB + hstep, voffB); PG8_STAGE(PG8_SA(0, 0), cA, voffA); PG8_STAGE(PG8_SA(0, 1), cA + hstep, voffA);
        if (wr == 1) PG8_BAR;
        PG8_WAIT_V(2); PG8_BAR;
        PG8_STAGE(PG8_SB(1, 0), cB + kstep, voffB); PG8_STAGE(PG8_SA(1, 0), cA + kstep, voffA); PG8_STAGE(PG8_SB(1, 1), cB + hstep + kstep, voffB);
        PG8_WAIT_V(6); PG8_BAR;
    } else {
        PG8_STAGE(PG8_SB(0, 0), cB, voffB); PG8_STAGE(PG8_SA(0, 0), cA, voffA); PG8_STAGE(PG8_SB(0, 1), cB + hstep, voffB); PG8_STAGE(PG8_SA(0, 1), cA + hstep, voffA);
        if (wr == 1) PG8_BAR;
        PG8_WAIT_V(4); PG8_BAR;
        PG8_STAGE(PG8_SB(1, 0), cB + kstep, voffB); PG8_STAGE(PG8_SA(1, 0), cA + kstep, voffA); PG8_STAGE(PG8_SB(1, 1), cB + hstep + kstep, voffB);
        PG8_WAIT_V(6); PG8_BAR;
    }
    for (;;) {
        const bool has_next = S.next(ui + 1, nxt);
        const char* nA = has_next ? (const char*)g.A + (size_t)nxt.pm * tstep : cA; const char* nB = has_next ? (const char*)g.Bt + (size_t)nxt.pn * tstep : cB;
        for (int t = 0; t < nt; t += 2) {
            if constexpr (Epi::HAS_MID) { if (t == nt / 2) { int t2_ = threadIdx.x; asm volatile("" : "+v"(t2_)); const int l2_ = t2_ & 63; E.mid(acc, cur, wr, wc, l2_ & 15, l2_ >> 4); } }
            const bool last = (t == nt - 2);
            const char* a1 = cA + (size_t)(t + 1) * kstep;
            const char* a2 = last ? nA : cA + (size_t)(t + 2) * kstep; const char* b2 = last ? nB : cB + (size_t)(t + 2) * kstep;
            const char* a3 = a2 + kstep; const char* b3 = b2 + kstep;
            if (last && has_next) S.a_ready(nxt);
            if constexpr (SP2) {
            PG8_LDB(B0, 0, 0); PG8_LDB(B1, 0, 1); PG8_SCHED; PG8_LDA(At, 0, 0); PG8_STAGE(PG8_SA(1, 1), a1 + hstep, voffA);
            PG8_WAIT_V(8); PG8_WAIT_L(0); PG8_BAR; PG8_MMA(0, 0, At, B0); PG8_MMA(0, 1, At, B1); PG8_BAR; PG8_SCHED;
            PG8_LDA(At, 0, 1); PG8_STAGE(PG8_SB(0, 0), b2, voffB); PG8_STAGE(PG8_SB(0, 1), b2 + hstep, voffB); PG8_STAGE(PG8_SA(0, 0), a2, voffA);
            PG8_WAIT_V(8); PG8_WAIT_L(0); PG8_BAR; PG8_MMA(1, 0, At, B0); PG8_MMA(1, 1, At, B1); PG8_BAR; PG8_SCHED;
            PG8_LDB(B0, 1, 0); PG8_LDB(B1, 1, 1); PG8_SCHED; PG8_LDA(At, 1, 0); PG8_STAGE(PG8_SA(0, 1), a2 + hstep, voffA);
            PG8_WAIT_V(8); PG8_WAIT_L(0); PG8_BAR; PG8_MMA(0, 0, At, B0); PG8_MMA(0, 1, At, B1); PG8_BAR; PG8_SCHED;
            PG8_LDA(At, 1, 1); PG8_STAGE(PG8_SB(1, 0), b3, voffB); PG8_STAGE(PG8_SB(1, 1), b3 + hstep, voffB); PG8_STAGE(PG8_SA(1, 0), a3, voffA);
            PG8_WAIT_V(8); PG8_WAIT_L(0); PG8_BAR; PG8_MMA(1, 0, At, B0); PG8_MMA(1, 1, At, B1); PG8_BAR; PG8_SCHED;
            } else {
            PG8_LDB(B0, 0, 0); PG8_SCHED; PG8_LDA(At, 0, 0); PG8_STAGE(PG8_SA(1, 1), a1 + hstep, voffA);
            PG8_WAIT_L(8); PG8_BAR; PG8_WAIT_L(0); PG8_MMA(0, 0, At, B0); PG8_BAR; PG8_SCHED;
            PG8_LDB(B1, 0, 1); PG8_STAGE(PG8_SB(0, 0), b2, voffB);
            PG8_BAR; PG8_WAIT_L(0); PG8_MMA(0, 1, At, B1); PG8_BAR;
            PG8_LDA(At, 0, 1); PG8_STAGE(PG8_SA(0, 0), a2, voffA);
            PG8_BAR; PG8_WAIT_L(0); PG8_MMA(1, 0, At, B0); PG8_BAR; PG8_SCHED;
            PG8_STAGE(PG8_SB(0, 1), b2 + hstep, voffB);
            PG8_WAIT_V(6); PG8_BAR; PG8_MMA(1, 1, At, B1); PG8_BAR;
            PG8_LDB(B0, 1, 0); PG8_SCHED; PG8_LDA(At, 1, 0); PG8_STAGE(PG8_SA(0, 1), a2 + hstep, voffA);
            PG8_WAIT_L(8); PG8_BAR; PG8_WAIT_L(0); PG8_MMA(0, 0, At, B0); PG8_BAR; PG8_SCHED;
            PG8_LDB(B1, 1, 1); PG8_STAGE(PG8_SB(1, 0), b3, voffB);
            PG8_BAR; PG8_WAIT_L(0); PG8_MMA(0, 1, At, B1); PG8_BAR;
            PG8_LDA(At, 1, 1); PG8_STAGE(PG8_SA(1, 0), a3, voffA);
            PG8_BAR; PG8_WAIT_L(0); PG8_MMA(1, 0, At, B0); PG8_BAR; PG8_SCHED;
            PG8_STAGE(PG8_SB(1, 1), b3 + hstep, voffB);
            PG8_WAIT_V(6); PG8_BAR; PG8_MMA(1, 1, At, B1); PG8_BAR;
            }
        }
        if constexpr (ALIGN_EPI) { if (wr == 0) PG8_BAR; }
        if constexpr (!Epi::AFTER_DRAIN) { { int t2_ = threadIdx.x; asm volatile("" : "+v"(t2_)); const int l2_ = t2_ & 63; E(acc, cur, wr, wc, l2_ & 15, l2_ >> 4); }     S.done(cur); }
        if (!has_next) break;
#pragma unroll
        for (int a = 0; a < 2; ++a)
#pragma unroll
            for (int b = 0; b < 2; ++b)
#pragma unroll
                for (int m = 0; m < 4; ++m)
#pragma unroll
                    for (int n = 0; n < 2; ++n) acc[a][b][m][n] = (f32x4){0.f, 0.f, 0.f, 0.f};
        cur = nxt; cA = nA; cB = nB; ++ui;
        if constexpr (ALIGN_EPI) { if (wr == 1) PG8_BAR; }
    }
    PG8_WAIT_V(0);
    if constexpr (!ALIGN_EPI) { if (wr == 0) PG8_BAR; }
    PG8_BAR;
    if constexpr (Epi::AFTER_DRAIN) { E.fused(acc, cur, wr, wc, fr, fq, lds, wid, lane); S.done(cur); }
#undef PG8_SA
#undef PG8_SB
#undef PG8_STAGE
#undef PG8_LDA
#undef PG8_LDB
#undef PG8_MMA
#undef PG8_WAIT_V
#undef PG8_WAIT_L
#undef PG8_BAR
#undef PG8_SCHED
}
}

constexpr int NWAVES = 8, NTHR = NWAVES * 64;
#ifndef MK_N_LAUNCHES
#define MK_N_LAUNCHES 1
#endif
#ifndef PROBE_DUP
#define PROBE_DUP -1
#endif
#ifndef USE_CHUNKED
#define USE_CHUNKED 1
#endif
#ifndef PROBE_P3MODE
#define PROBE_P3MODE 0
#endif
constexpr int PER_PHASE = 10;
constexpr int N_LAUNCHES = MK_N_LAUNCHES;

constexpr int DM = 2048, SEQ = 2048, NB = 4, MP = NB * SEQ  , MS = 128, MV = MP + MS  , MPAD = 8448  ;
constexpr int DA = 1024, NH = 16, HD = 64, SHW = 3200, PSW = 3328, N1 = 11520, NIN = 11392, CK = 31, PLE = 256;
constexpr float RMS_EPS = 1e-6f, LN_EPS = 1e-5f, GN_EPS = 64e-5f;
static_assert(MV == pg8::E_MV, "row count");
constexpr size_t O_YP = 0, O_YS = (size_t)MP * DM, O_SHP = O_YS + (size_t)MS * DM, O_WKP = O_SHP + (size_t)NB * SHW, O_CVP = O_WKP + (size_t)NB * NH * HD * HD,
                 O_SHS = O_CVP + (size_t)NB * 30 * DA, O_WKS = O_SHS + (size_t)MS * SHW, O_CVS = O_WKS + (size_t)MS * NH * HD * HD, O_END = O_CVS + (size_t)MS * 30 * DA;
static_assert(O_END == 30167552, "output size");

constexpr size_t MiB = 1u << 20;
constexpr size_t WS_CTL = 0, CTL_ZERO_BYTES = 1 * MiB;
constexpr size_t WS_WAT = 1 * MiB, WS_WBT = 5 * MiB, WS_WOT = 9 * MiB, WS_WGT = 17 * MiB, WS_WPT = 25 * MiB, WS_WLT = 26 * MiB, WS_ALT = 26 * MiB + 128 * 1024, WS_PB = 27 * MiB;
constexpr size_t WS_GA = 32 * MiB, WS_GLU = 49 * MiB, WS_GB = 82 * MiB, WS_MG = 99 * MiB;
constexpr size_t WS_Y = 165 * MiB;
constexpr size_t WS_PS = WS_Y, WS_OA = WS_Y, WS_CB = WS_Y + 1024 * 2, WS_HB = WS_Y;
constexpr int OAS = 2048;
constexpr size_t WS_X = 219 * MiB;
constexpr size_t WS_WTIN = WS_X, WS_XN = WS_X + 45 * MiB;
constexpr size_t SCAN_N = (size_t)65 * 2048 * 64;
constexpr size_t WS_SW = WS_X, WS_SA = WS_SW + SCAN_N * 4, WS_SB = WS_SA + SCAN_N * 2, WS_SK = WS_SB + SCAN_N * 2, WS_SWR = WS_SK + SCAN_N * 2, WS_SV = WS_SWR + SCAN_N * 2,
                 WS_SBR = WS_SV + SCAN_N * 2, WS_SKR = WS_SBR + 65 * 2048 * 4, WS_SBS = WS_SKR + 65 * 2048 * 4, WS_SEND = WS_SBS + 65 * 2048 * 4;
constexpr size_t WS_T = WS_X, WS_MB = WS_X + 66 * MiB, WS_H2B = WS_X + 33 * MiB;
constexpr size_t WS_E = WS_GLU;
constexpr size_t WS_END = 335 * MiB;
static_assert(WS_PB + (size_t)MPAD * PLE * 2 <= WS_GA && WS_GA + (size_t)MPAD * 1024 * 2 <= WS_GLU && WS_GLU + (size_t)MPAD * 2048 * 2 <= WS_GB && WS_GB + (size_t)MPAD * 1024 * 2 <= WS_MG &&
              WS_MG + (size_t)MPAD * 4096 * 2 <= WS_Y && WS_PS + (size_t)MPAD * PSW * 2 <= WS_X && WS_OA + (size_t)MPAD * OAS * 2 <= WS_X &&
              WS_WTIN + (size_t)N1 * DM * 2 <= WS_XN && WS_XN + (size_t)MPAD * DM * 2 <= WS_END && WS_SEND <= WS_END && WS_T + (size_t)MPAD * DM * 4 <= WS_MB && WS_MB + (size_t)MPAD * DM * 2 <= WS_END &&
              WS_HB + (size_t)MPAD * DM * 2 <= WS_X, "d_ws map");
constexpr int CW_ROWSQ = 65536;
constexpr int FUSE_NORM = 1;
constexpr int LATE_IN_P1 = 0;
constexpr int CW_BAR = 4096;

constexpr int RING_BYTES = 131072, LDSCTL_OFF = 143360  , MISC_OFF = LDSCTL_OFF + 320, LDS_BYTES = 147456;

#define GAS __attribute__((address_space(1)))
#define LAS __attribute__((address_space(3)))
typedef unsigned short bf16;
typedef unsigned v4u __attribute__((ext_vector_type(4)));
typedef unsigned v2u __attribute__((ext_vector_type(2)));
typedef float f32x4 __attribute__((ext_vector_type(4)));
typedef float f32x2 __attribute__((ext_vector_type(2)));
typedef short bf16x8 __attribute__((ext_vector_type(8)));
typedef GAS unsigned gu32;
#define RLX_AGENT __ATOMIC_RELAXED, __HIP_MEMORY_SCOPE_AGENT
#define LDS_WAIT() asm volatile("s_waitcnt lgkmcnt(0)" ::: "memory")
#define VM_WAIT() asm volatile("s_waitcnt vmcnt(0)" ::: "memory")
#define LDS_BAR() asm volatile("s_waitcnt lgkmcnt(0)\n\ts_barrier" ::: "memory")
typedef __bf16 bf16x2_hw __attribute__((ext_vector_type(2)));
__device__ __forceinline__ unsigned pk2(float lo, float hi) { const f32x2 v = {lo, hi}; const bf16x2_hw b = __builtin_convertvector(v, bf16x2_hw); return __builtin_bit_cast(unsigned, b); }
__device__ __forceinline__ unsigned f2bf(float f) { return pk2(f, f) & 0xffffu; }
__device__ __forceinline__ float bflo(unsigned u) { return __uint_as_float(u << 16); }
__device__ __forceinline__ float bfhi(unsigned u) { return __uint_as_float(u & 0xffff0000u); }
__device__ __forceinline__ float bf1(bf16 b) { return __uint_as_float((unsigned)b << 16); }
__device__ __forceinline__ float sigm(float x) { return __builtin_amdgcn_rcpf(1.0f + __expf(-x)); }
__device__ __forceinline__ float silu2(float x, float y) { return (x * y) * __builtin_amdgcn_rcpf((1.0f + __expf(-x)) * (1.0f + __expf(-y))); }
__device__ __forceinline__ float tanh_fast(float x) { return 1.0f - 2.0f * __builtin_amdgcn_rcpf(1.0f + __expf(2.0f * x)); }
template <int CTRL> __device__ __forceinline__ float dpp_f(float x) { return __builtin_bit_cast(float, __builtin_amdgcn_update_dpp(0, __builtin_bit_cast(int, x), CTRL, 0xf, 0xf, true)); }
__device__ __forceinline__ float reduce16(float x) { x += dpp_f<0xB1>(x); x += dpp_f<0x4E>(x); x += dpp_f<0x124>(x); x += dpp_f<0x128>(x); return x; }
__device__ __forceinline__ float wave_sum(float v) {
    const int i = __builtin_bit_cast(int, reduce16(v));
    return (__builtin_bit_cast(float, __builtin_amdgcn_readlane(i, 0)) + __builtin_bit_cast(float, __builtin_amdgcn_readlane(i, 16))) +
           (__builtin_bit_cast(float, __builtin_amdgcn_readlane(i, 32)) + __builtin_bit_cast(float, __builtin_amdgcn_readlane(i, 48)));
}

__device__ __forceinline__ float row_sum4(float v) {
    const int i = __builtin_bit_cast(int, v);
    return (__builtin_bit_cast(float, __builtin_amdgcn_readlane(i, 0)) + __builtin_bit_cast(float, __builtin_amdgcn_readlane(i, 16))) +
           (__builtin_bit_cast(float, __builtin_amdgcn_readlane(i, 32)) + __builtin_bit_cast(float, __builtin_amdgcn_readlane(i, 48)));
}

#define XB_TMO      128
#define XB_XCNT(j)  (256  + 64 * (j))
#define XB_XSUB(j)  (1280 + 64 * (j))
#define XB_XGEN(j)  (2304 + 64 * (j))
#define XB_TOP      3328
#define XB_TOPGEN   3392
#define XCD_BAR_WORDS 3456
#define XB_SPIN_CAP (1u << 18)
__device__ __forceinline__ unsigned xb_ld(unsigned* p)              { return __hip_atomic_load(p, __ATOMIC_RELAXED, __HIP_MEMORY_SCOPE_AGENT); }
__device__ __forceinline__ unsigned xb_add(unsigned* p, unsigned v) { return __hip_atomic_fetch_add(p, v, __ATOMIC_RELAXED, __HIP_MEMORY_SCOPE_AGENT); }
__device__ __forceinline__ unsigned xb_xcc_id() { return (unsigned)__builtin_amdgcn_s_getreg((3 << 11) | 20) & 0xFu; }
#define XB_SPIN(cond, bar) do { unsigned _sp = 0; while (cond) { __builtin_amdgcn_s_sleep(1); \
    if ((++_sp & 255u) == 0u) { if (xb_ld(&(bar)[XB_TMO])) break; if (_sp > XB_SPIN_CAP) { atomicAdd(&(bar)[XB_TMO], 1u); break; } } } } while (0)
struct XcdBarrier { unsigned* bar; unsigned x; volatile LAS unsigned* st; };
__device__ __forceinline__ XcdBarrier xcd_barrier_post(unsigned* bar, volatile LAS unsigned* st) {
    XcdBarrier b; b.bar = bar; b.x = xb_xcc_id(); b.st = st;
    if (threadIdx.x == 0) (void)xb_add(&bar[XB_XCNT(b.x)], 1u);
    return b;
}
__device__ __forceinline__ void xcd_barrier_complete(unsigned* bar, unsigned x, unsigned& nloc, unsigned& nx) {
    const unsigned G = gridDim.x * gridDim.y * gridDim.z;
    unsigned sum, cnt, mine, sp = 0u;
    for (;;) {
        sum = 0u; cnt = 0u; mine = 0u;
#pragma unroll
        for (unsigned j = 0; j < 16; ++j) { const unsigned c = xb_ld(&bar[XB_XCNT(j)]); sum += c; cnt += (c > 0u) ? 1u : 0u; mine = (j == x) ? c : mine; }
        if (sum == G) break;
        __builtin_amdgcn_s_sleep(1);
        if ((++sp & 255u) == 0u) { if (xb_ld(&bar[XB_TMO])) break; if (sp > XB_SPIN_CAP) { atomicAdd(&bar[XB_TMO], 1u); break; } }
    }
    nloc = mine > 0u ? mine : 1u; nx = cnt > 0u ? cnt : 1u;
}
__device__ __forceinline__ void xcd_barrier(const XcdBarrier& b) {
    asm volatile("s_waitcnt vmcnt(0)" ::: "memory");
    __syncthreads();
    if (threadIdx.x == 0) {
        unsigned* bar = b.bar;
        __builtin_amdgcn_s_waitcnt(0);
        unsigned nloc = b.st[0], nx = b.st[1];
        if (nloc == 0u) { xcd_barrier_complete(bar, b.x, nloc, nx); b.st[0] = nloc; b.st[1] = nx; }
        const unsigned old = xb_add(&bar[XB_XSUB(b.x)], 1u);
        const unsigned gen = old / nloc;
        if (old + 1u == (gen + 1u) * nloc) {
            __builtin_amdgcn_fence(__ATOMIC_RELEASE, "agent");
            asm volatile("s_waitcnt vmcnt(0)" ::: "memory");
            const unsigned og = xb_add(&bar[XB_TOP], 1u);
            const unsigned tg = og / nx;
            if (og + 1u == (tg + 1u) * nx) xb_add(&bar[XB_TOPGEN], 1u);
            else XB_SPIN(xb_ld(&bar[XB_TOPGEN]) == tg, bar);
            __builtin_amdgcn_fence(__ATOMIC_ACQUIRE, "agent");
            xb_add(&bar[XB_XGEN(b.x)], 1u);
            asm volatile("s_waitcnt vmcnt(0)" ::: "memory");
        } else {
            XB_SPIN(xb_ld(&bar[XB_XGEN(b.x)]) == gen, bar);
            __builtin_amdgcn_fence(__ATOMIC_ACQUIRE, "agent");
            asm volatile("s_waitcnt vmcnt(0)" ::: "memory");
        }
    }
    __syncthreads();
}

struct Args { const float* in[29]; float* out; unsigned char* ws; int ph_lo, ph_hi, li, pad; };
struct PArgs { LAS unsigned char* lds; };
__device__ __forceinline__ const float* argp(const PArgs& a, int i) {
    const v2u p = *(const LAS v2u*)(a.lds + LDSCTL_OFF + 8 * i);
    const unsigned long long q = ((unsigned long long)(unsigned)__builtin_amdgcn_readfirstlane((int)p.y) << 32) | (unsigned)__builtin_amdgcn_readfirstlane((int)p.x);
    return (const float*)(const GAS float*)q;
}
#define A_IN(i) argp(a, (i))
#define A_OUT ((float*)argp(a, 29))
#define A_WS ((unsigned char*)argp(a, 30))
__device__ __forceinline__ int opaque_tid() { int t = threadIdx.x; asm volatile("" : "+v"(t)); return t; }
enum { I_XP = 0, I_XS, I_SSHIFT, I_SWKV, I_SCONV, I_PP, I_PS, I_NORMG, I_WIN, I_MU, I_W0, I_WLB, I_A0, I_ALB, I_KK, I_KA, I_RK, I_LNXG, I_LNXB, I_WPA, I_CONVW, I_CONVB, I_CLNG, I_CLNB, I_WPB, I_WOUT,
       I_WPLE, I_WPG, I_FING };

__device__ __forceinline__ void p0_transpose_item(const float* W, int K, int N, bf16* WT, int gap_at, LAS float* scr, int item, int lane, int ldk = 0, int koff = 0) {
    if (ldk == 0) ldk = K;
    const int nblk = N / 32, kb = item / nblk, nb = item % nblk, k0 = 64 * kb, n0 = 32 * nb, row_off = (n0 >= gap_at) ? 128 : 0;
    int n0d = n0; if (gap_at == SHW && n0 >= 4224 && n0 < 4224 + 2048) { const int j_ = n0 - 4224, ch_ = j_ & 1023, gt_ = j_ >> 10; n0d = 4224 + (ch_ >> 7) * 256 + gt_ * 128 + (ch_ & 127); }
#pragma unroll
    for (int i = 0; i < 8; ++i) { const int kk = 8 * i + (lane >> 3), n4 = (lane & 7) * 4; const f32x4 v = __builtin_nontemporal_load((const f32x4*)(W + (size_t)(k0 + kk) * N + n0 + n4));
        LAS float* d = scr + kk * 33 + n4; d[0] = v.x; d[1] = v.y; d[2] = v.z; d[3] = v.w; }
    LDS_WAIT(); asm volatile("" ::: "memory");
    const int c = lane & 7;
#pragma unroll
    for (int j = 0; j < 4; ++j) { const int n = (lane >> 3) + 8 * j; const LAS float* s = scr + (8 * c) * 33 + n;
        v4u o; o.x = pk2(s[0 * 33], s[1 * 33]); o.y = pk2(s[2 * 33], s[3 * 33]); o.z = pk2(s[4 * 33], s[5 * 33]); o.w = pk2(s[6 * 33], s[7 * 33]);
        *(GAS v4u*)(WT + (size_t)(row_off + n0d + n) * ldk + koff + k0 + 8 * c) = o; }
    LDS_WAIT(); asm volatile("" ::: "memory");
}
__device__ __forceinline__ void p0_prologue(const PArgs& a, LAS unsigned char* lds, int lane, int wave, int vcu, int G) {
    unsigned char* ws = A_WS;
    LAS float* scr = (LAS float*)(lds + wave * 16384);
    const int gw = vcu * NWAVES + wave, NGW = G * NWAVES;
    constexpr int NOGAP = 1 << 30;
    constexpr int I_IN = (DM / 64) * (NIN / 32), I_A = (DA / 64) * (DM / 32), I_O = (DM / 64) * (DM / 32), I_P = (PLE / 64) * (DM / 32), I_L = (64 / 64) * (DA / 32);
    constexpr int NITEMS = I_IN + 2 * I_L;
    for (int it = gw; it < NITEMS; it += NGW) {
        int r = it;
        if (r < I_IN) { p0_transpose_item(A_IN(I_WIN), DM, NIN, (bf16*)(ws + WS_WTIN), SHW, scr, r, lane); continue; } r -= I_IN;
        if (r < I_L) { p0_transpose_item(A_IN(I_WLB), 64, DA, (bf16*)(ws + WS_WLT), NOGAP, scr, r, lane); continue; } r -= I_L;
        p0_transpose_item(A_IN(I_ALB), 64, DA, (bf16*)(ws + WS_ALT), NOGAP, scr, r, lane);
    }
    { GAS v4u* z = (GAS v4u*)(ws + WS_WTIN + (size_t)SHW * DM * 2); for (int i = gw * 64 + lane; i < 128 * DM * 2 / 16; i += NGW * 64) z[i] = (v4u){0u, 0u, 0u, 0u}; }
    const float* xp = A_IN(I_XP); const float* xs = A_IN(I_XS); const float* ng = A_IN(I_NORMG);
    bf16* XN = (bf16*)(ws + WS_XN);
    for (int m = gw; m < MPAD; m += NGW) {
        GAS v2u* o8 = (GAS v2u*)(XN + (size_t)m * DM) + lane;
        if (m >= MV) {
#pragma unroll
            for (int j = 0; j < 8; ++j) o8[64 * j] = (v2u){0u, 0u};
            continue; }
        const GAS f32x4* xr = (const GAS f32x4*)(m < MP ? xp + (size_t)m * DM : xs + (size_t)(m - MP) * DM) + lane;
        f32x4 v[8]; float s = 0.f;
#pragma unroll
        for (int j = 0; j < 8; ++j) { v[j] = __builtin_nontemporal_load(&xr[64 * j]); s += (v[j].x * v[j].x + v[j].y * v[j].y) + (v[j].z * v[j].z + v[j].w * v[j].w); }
        const float rs = 1.0f / sqrtf(wave_sum(s) * (1.0f / DM) + RMS_EPS);
#pragma unroll
        for (int j = 0; j < 8; ++j) { const f32x4 g = ((const GAS f32x4*)ng)[lane + 64 * j]; const f32x4 y = v[j] * rs * g; o8[64 * j] = (v2u){pk2(y.x, y.y), pk2(y.z, y.w)}; }
    }
    const float* pp = A_IN(I_PP); const float* ps = A_IN(I_PS);
    bf16* PB = (bf16*)(ws + WS_PB);
    for (int m = gw; m < MPAD; m += NGW) {
        GAS v2u* o8 = (GAS v2u*)(PB + (size_t)m * PLE) + lane;
        if (m >= MV) { *o8 = (v2u){0u, 0u}; continue; }
        const f32x4 v = ((const GAS f32x4*)(m < MP ? pp + (size_t)m * PLE : ps + (size_t)(m - MP) * PLE))[lane];
        *o8 = (v2u){pk2(v.x, v.y), pk2(v.z, v.w)};
    }
}

__device__ __forceinline__ void late_weights(const PArgs& a, LAS unsigned char* lds, int lane, int wave, int grp, int gwi, int ngw) {
    unsigned char* ws = A_WS;
    LAS float* scr = (LAS float*)(lds + wave * 16384);
    constexpr int NOGAP = 1 << 30;
    constexpr int I_A = (DA / 64) * (DM / 32), I_O = (DM / 64) * (DM / 32), I_P = (PLE / 64) * (DM / 32);
    if (grp == 0) {
        for (int r = gwi; r < 2 * I_A; r += ngw) {
            if (r < I_A) p0_transpose_item(A_IN(I_WPA), DA, DM, (bf16*)(ws + WS_WAT), NOGAP, scr, r, lane, 2 * DA, 0);
            else p0_transpose_item(A_IN(I_WPB), DA, DM, (bf16*)(ws + WS_WAT), NOGAP, scr, r - I_A, lane, 2 * DA, DA); }
    } else {
        for (int r = gwi; r < 2 * I_O + I_P; r += ngw) {
            if (r < I_O) p0_transpose_item(A_IN(I_WOUT), DM, DM, (bf16*)(ws + WS_WOT), NOGAP, scr, r, lane);
            else if (r < 2 * I_O) p0_transpose_item(A_IN(I_WPG), DM, DM, (bf16*)(ws + WS_WGT), NOGAP, scr, r - I_O, lane);
            else p0_transpose_item(A_IN(I_WPLE), PLE, DM, (bf16*)(ws + WS_WPT), NOGAP, scr, r - 2 * I_O, lane); }
    }
}

struct PrepC { float mur, muk, muv, w0, a0, kk, ka, rk; };
__device__ __forceinline__ void prep_phase(const PArgs& a, LAS unsigned char* lds, int tid, int lane, int wave) {
    unsigned char* ws = A_WS;
    const bf16* PS = (const bf16*)(ws + WS_PS); const bf16* WlT = (const bf16*)(ws + WS_WLT); const bf16* AlT = (const bf16*)(ws + WS_ALT);
    const float* mu = A_IN(I_MU); const float* sst = A_IN(I_SSHIFT);
    float* SW = (float*)(ws + WS_SW); bf16* SA = (bf16*)(ws + WS_SA); bf16* SB = (bf16*)(ws + WS_SB); bf16* SK = (bf16*)(ws + WS_SK); bf16* SWR = (bf16*)(ws + WS_SWR); bf16* SV = (bf16*)(ws + WS_SV);
    float* SBR = (float*)(ws + WS_SBR); float* SKR = (float*)(ws + WS_SKR); float* SBS = (float*)(ws + WS_SBS);
    LAS bf16* Aw = (LAS bf16*)lds; LAS bf16* Aa = Aw + 16 * 64;
    const int fr = lane & 15, fq = lane >> 4;
    for (int it = blockIdx.x; it < MP / 16; it += gridDim.x) {
        const int m0 = it * 16;
        {
            const int tok = tid >> 5, j = (tid & 31) * 4, m = m0 + tok, col = 3072 + j;
            const v2u pc = *(const v2u*)(PS + (size_t)m * PSW + col);
            f32x4 p = {bflo(pc.x), bfhi(pc.x), bflo(pc.y), bfhi(pc.y)}, q = {0.f, 0.f, 0.f, 0.f};
            if (m < MP) { if ((m & (SEQ - 1)) != 0) { const v2u qc = *(const v2u*)(PS + (size_t)(m - 1) * PSW + col); q = (f32x4){bflo(qc.x), bfhi(qc.x), bflo(qc.y), bfhi(qc.y)}; } }
            else q = *(const f32x4*)(sst + (size_t)(m - MP) * SHW + col);
            const f32x4 mu4 = *(const f32x4*)(mu + col);
            f32x4 x = p + mu4 * (q - p);
            if (j < 64) { x.x = tanh_fast(x.x); x.y = tanh_fast(x.y); x.z = tanh_fast(x.z); x.w = tanh_fast(x.w); }
            LAS bf16* dst = (j < 64) ? (Aw + tok * 64 + j) : (Aa + tok * 64 + (j - 64));
            *(LAS v2u*)dst = (v2u){pk2(x.x, x.y), pk2(x.z, x.w)};
        }
        if (m0 >= MP) { for (int idx = tid; idx < 16 * (SHW / 4); idx += NTHR) { const int tok = idx / (SHW / 4), c4 = (idx % (SHW / 4)) * 4; const v2u v = *(const v2u*)(PS + (size_t)(m0 + tok) * PSW + c4);
                *(f32x4*)(A_OUT + O_SHS + (size_t)(m0 - MP + tok) * SHW + c4) = (f32x4){bflo(v.x), bfhi(v.x), bflo(v.y), bfhi(v.y)}; } }
        else if ((m0 & (SEQ - 1)) == SEQ - 16) { const int b = m0 / SEQ; for (int idx = tid; idx < SHW / 4; idx += NTHR) { const int c4 = idx * 4; const v2u v = *(const v2u*)(PS + (size_t)(m0 + 15) * PSW + c4);
                *(f32x4*)(A_OUT + O_SHP + (size_t)b * SHW + c4) = (f32x4){bflo(v.x), bfhi(v.x), bflo(v.y), bfhi(v.y)}; } }
        LDS_WAIT(); __syncthreads();
        bf16x8 aw[2], aa[2];
#pragma unroll
        for (int kb = 0; kb < 2; ++kb) { aw[kb] = *(const LAS bf16x8*)(Aw + fr * 64 + kb * 32 + 8 * fq); aa[kb] = *(const LAS bf16x8*)(Aa + fr * 64 + kb * 32 + 8 * fq); }
        const int mq = m0 + 4 * fq;
#pragma unroll 1
        for (int hh = 0; hh < 2; ++hh) {
            const int h = wave * 2 + hh;
            f32x4 lw[4], la[4]; PrepC C[4];
#pragma unroll
            for (int blk = 0; blk < 4; ++blk) {
                const int ch = h * 64 + blk * 16 + fr;
                const bf16x8 bw0 = *(const bf16x8*)(WlT + (size_t)ch * 64 + 8 * fq), bw1 = *(const bf16x8*)(WlT + (size_t)ch * 64 + 32 + 8 * fq);
                const bf16x8 ba0 = *(const bf16x8*)(AlT + (size_t)ch * 64 + 8 * fq), ba1 = *(const bf16x8*)(AlT + (size_t)ch * 64 + 32 + 8 * fq);
                f32x4 z = {0.f, 0.f, 0.f, 0.f};
                lw[blk] = __builtin_amdgcn_mfma_f32_16x16x32_bf16(aw[0], bw0, z, 0, 0, 0); lw[blk] = __builtin_amdgcn_mfma_f32_16x16x32_bf16(aw[1], bw1, lw[blk], 0, 0, 0);
                la[blk] = __builtin_amdgcn_mfma_f32_16x16x32_bf16(aa[0], ba0, z, 0, 0, 0); la[blk] = __builtin_amdgcn_mfma_f32_16x16x32_bf16(aa[1], ba1, la[blk], 0, 0, 0);
                C[blk].mur = mu[ch]; C[blk].muk = mu[1024 + ch]; C[blk].muv = mu[2048 + ch]; C[blk].w0 = A_IN(I_W0)[ch]; C[blk].a0 = A_IN(I_A0)[ch];
                C[blk].kk = A_IN(I_KK)[ch]; C[blk].ka = A_IN(I_KA)[ch]; C[blk].rk = A_IN(I_RK)[ch];
            }
            float cR[4][4], cK[4][4], cV[4][4], pR[4], pK[4], pV[4];
#pragma unroll
            for (int reg = 0; reg < 4; ++reg)
#pragma unroll
                for (int blk = 0; blk < 4; ++blk) { const bf16* pr = PS + (size_t)(mq + reg) * PSW + h * 64 + blk * 16 + fr; cR[reg][blk] = bf1(pr[0]); cK[reg][blk] = bf1(pr[1024]); cV[reg][blk] = bf1(pr[2048]); }
            {   const bool has_prev = mq < MP && (mq & (SEQ - 1)) != 0;
#pragma unroll
                for (int blk = 0; blk < 4; ++blk) { const bf16* pr = PS + (size_t)(has_prev ? mq - 1 : mq) * PSW + h * 64 + blk * 16 + fr;
                    const float r0 = bf1(pr[0]), k0 = bf1(pr[1024]), v0 = bf1(pr[2048]); pR[blk] = has_prev ? r0 : 0.f; pK[blk] = has_prev ? k0 : 0.f; pV[blk] = has_prev ? v0 : 0.f; } }
#pragma unroll
            for (int reg = 0; reg < 4; ++reg) {
                const int m = mq + reg;
                float r_[4], kf_[4], v_[4], kkr_[4], al_[4], dc_[4];
                float n2 = 0.f, sbr = 0.f, skr = 0.f, sbs = 0.f;
                if (m >= MP) {
#pragma unroll
                    for (int blk = 0; blk < 4; ++blk) { const float* st = sst + (size_t)(m - MP) * SHW + h * 64 + blk * 16 + fr; pR[blk] = st[0]; pK[blk] = st[1024]; pV[blk] = st[2048]; }
                }
#pragma unroll
                for (int blk = 0; blk < 4; ++blk) {
                    const float cr = cR[reg][blk], ck = cK[reg][blk], cv = cV[reg][blk];
                    const float r = cr + C[blk].mur * (pR[blk] - cr), k = ck + C[blk].muk * (pK[blk] - ck), v = cv + C[blk].muv * (pV[blk] - cv);
                    pR[blk] = cr; pK[blk] = ck; pV[blk] = cv;
                    const float sg = sigm(C[blk].w0 + lw[blk][reg]);
                    const float dc = __expf(-0.6065306597126334f * sg);
                    const float al = sigm(C[blk].a0 + la[blk][reg]);
                    const float kkr = k * C[blk].kk, kf = k * (1.0f + (al - 1.0f) * C[blk].ka);
                    n2 += kkr * kkr; sbr += kkr * al * r; skr += kf * r; sbs += r * kf * C[blk].rk;
                    r_[blk] = r; kf_[blk] = kf; v_[blk] = v; kkr_[blk] = kkr; al_[blk] = al; dc_[blk] = dc;
                }
                n2 = reduce16(n2); sbr = reduce16(sbr); skr = reduce16(skr); sbs = reduce16(sbs);
                const float inv = 1.0f / fmaxf(sqrtf(n2), 1e-12f);
                const size_t tix = (size_t)((m / SEQ) * NH + h) * SEQ + (m & (SEQ - 1));
                LAS float* oW = (LAS float*)(lds + 8192 + wave * 14336); LAS bf16* oB = (LAS bf16*)(oW + 1024);
#pragma unroll
                for (int blk = 0; blk < 4; ++blk) {
                    const int o = (4 * fq + reg) * 64 + blk * 16 + fr; const float kk = kkr_[blk] * inv;
                    oW[o] = dc_[blk]; oB[o] = (bf16)f2bf(-kk); oB[1024 + o] = (bf16)f2bf(kk * al_[blk]); oB[2048 + o] = (bf16)f2bf(kf_[blk]);
                    oB[3072 + o] = (bf16)f2bf(USE_CHUNKED ? r_[blk] : dc_[blk] * r_[blk]); oB[4096 + o] = (bf16)f2bf(v_[blk]);
                }
                if (fr == 0) { SBR[tix] = sbr * inv; SKR[tix] = skr; SBS[tix] = sbs; }
            }
            {
                LDS_WAIT(); __builtin_amdgcn_wave_barrier(); asm volatile("" ::: "memory");
                const LAS float* oW = (const LAS float*)(lds + 8192 + wave * 14336); const LAS bf16* oB = (const LAS bf16*)(oW + 1024);
                const size_t t0x = ((size_t)((m0 / SEQ) * NH + h) * SEQ + (m0 & (SEQ - 1))) * 64;
#pragma unroll
                for (int i = 0; i < 4; ++i) *(f32x4*)(SW + t0x + 4 * (lane + 64 * i)) = *(const LAS f32x4*)(oW + 4 * (lane + 64 * i));
#pragma unroll
                for (int i = 0; i < 2; ++i) { const int e = 8 * (lane + 64 * i);
                    *(v4u*)(SA + t0x + e) = *(const LAS v4u*)(oB + e); *(v4u*)(SB + t0x + e) = *(const LAS v4u*)(oB + 1024 + e); *(v4u*)(SK + t0x + e) = *(const LAS v4u*)(oB + 2048 + e);
                    *(v4u*)(SWR + t0x + e) = *(const LAS v4u*)(oB + 3072 + e); *(v4u*)(SV + t0x + e) = *(const LAS v4u*)(oB + 4096 + e); }
                LDS_WAIT(); __builtin_amdgcn_wave_barrier(); asm volatile("" ::: "memory");
            }
        }
        __syncthreads();
    }
}

__device__ __forceinline__ float reduce16_asm(float x) {
    float r;
    asm("s_nop 1\n\tv_add_f32_dpp %0, %1, %1 quad_perm:[1,0,3,2] row_mask:0xf bank_mask:0xf" : "=v"(r) : "v"(x)); x = r;
    asm("s_nop 1\n\tv_add_f32_dpp %0, %1, %1 quad_perm:[2,3,0,1] row_mask:0xf bank_mask:0xf" : "=v"(r) : "v"(x)); x = r;
    asm("s_nop 1\n\tv_add_f32_dpp %0, %1, %1 row_ror:4 row_mask:0xf bank_mask:0xf" : "=v"(r) : "v"(x)); x = r;
    asm("s_nop 1\n\tv_add_f32_dpp %0, %1, %1 row_ror:8 row_mask:0xf bank_mask:0xf" : "=v"(r) : "v"(x)); return r;
}
__device__ __forceinline__ void reduce16x2_asm(float& x, float& y) {
    asm("s_nop 1\n\t"
        "v_add_f32_dpp %0, %0, %0 quad_perm:[1,0,3,2] row_mask:0xf bank_mask:0xf\n\tv_add_f32_dpp %1, %1, %1 quad_perm:[1,0,3,2] row_mask:0xf bank_mask:0xf\n\ts_nop 0\n\t"
        "v_add_f32_dpp %0, %0, %0 quad_perm:[2,3,0,1] row_mask:0xf bank_mask:0xf\n\tv_add_f32_dpp %1, %1, %1 quad_perm:[2,3,0,1] row_mask:0xf bank_mask:0xf\n\ts_nop 0\n\t"
        "v_add_f32_dpp %0, %0, %0 row_ror:4 row_mask:0xf bank_mask:0xf\n\tv_add_f32_dpp %1, %1, %1 row_ror:4 row_mask:0xf bank_mask:0xf\n\ts_nop 0\n\t"
        "v_add_f32_dpp %0, %0, %0 row_ror:8 row_mask:0xf bank_mask:0xf\n\tv_add_f32_dpp %1, %1, %1 row_ror:8 row_mask:0xf bank_mask:0xf"
        : "+v"(x), "+v"(y));
}
__device__ __forceinline__ void scan_prompt(const PArgs& a, LAS unsigned char* lds, int tid, int lane, int wave, int item) {
    unsigned char* ws = A_WS;
    constexpr int CT = 32, NCH = SEQ / CT, BUFSZ = 5 * 2048 + 512 + 64;
    LAS float* buf0 = (LAS float*)lds; LAS float* ybuf0 = buf0 + 2 * BUFSZ;
    const int bh = item >> 2, rq = item & 3, b = bh >> 4, h = bh & 15;
    if (wave < 4) {
        const int rl = wave * 4 + (lane >> 4), cg = lane & 15;
        f32x2 s01 = {0.f, 0.f}, s23 = {0.f, 0.f};
        __syncthreads();
#pragma unroll 1
        for (int c = 0; c < NCH; ++c) {
            const LAS float* B = buf0 + (c & 1) * BUFSZ; LAS float* yb = ybuf0 + (c & 1) * 512 + rl * 32;
            const LAS float* pc = B + 4 * cg;
            f32x4 cw = *(const LAS f32x4*)pc, ca = *(const LAS f32x4*)(pc + 2048), cb = *(const LAS f32x4*)(pc + 4096), ck = *(const LAS f32x4*)(pc + 6144), cwr = *(const LAS f32x4*)(pc + 8192);
            float cv = B[10240 + rl]; f32x2 csc = *(const LAS f32x2*)(B + 10752);
            f32x4 y4; float yq = 0.f, yz = 0.f;
#pragma unroll 1
            for (int tk4 = 0; tk4 < CT; tk4 += 4) {
#pragma unroll
                for (int u4 = 0; u4 < 4; ++u4) {
                    const int tk = tk4 + u4;
                    const int tn = (tk + 1 < CT) ? tk + 1 : tk;
                    const LAS float* pn = pc + tn * 64;
                    const f32x4 nw = *(const LAS f32x4*)pn, na = *(const LAS f32x4*)(pn + 2048), nb = *(const LAS f32x4*)(pn + 4096), nk = *(const LAS f32x4*)(pn + 6144), nwr = *(const LAS f32x4*)(pn + 8192);
                    const float nv = B[10240 + tn * 16 + rl]; const f32x2 nsc = *(const LAS f32x2*)(B + 10752 + tn * 2);
                    f32x2 p = s01 * (f32x2){ca.x, ca.y}; p = s23 * (f32x2){ca.z, ca.w} + p;
                    f32x2 q = s01 * (f32x2){cwr.x, cwr.y}; q = s23 * (f32x2){cwr.z, cwr.w} + q;
                    const f32x2 b01 = s01 * (f32x2){cw.x, cw.y} + (f32x2){ck.x, ck.y} * cv, b23 = s23 * (f32x2){cw.z, cw.w} + (f32x2){ck.z, ck.w} * cv;
                    float d0 = p.x + p.y, yr = yq;
                    reduce16x2_asm(d0, yr);
                    s01 = (f32x2){cb.x, cb.y} * d0 + b01; s23 = (f32x2){cb.z, cb.w} * d0 + b23;
                    const float yprev = yr + yz;
                    if (u4 == 0) { if (tk4 > 0) { y4[3] = yprev; if (cg == 0) *(LAS f32x4*)(yb + tk4 - 4) = y4; } } else y4[u4 - 1] = yprev;
                    yq = q.x + q.y; yz = d0 * csc.x + cv * csc.y;
                    cw = nw; ca = na; cb = nb; ck = nk; cwr = nwr; cv = nv; csc = nsc;
                }
            }
            { float dmy = 0.f; reduce16x2_asm(yq, dmy); y4[3] = yq + yz; if (cg == 0) *(LAS f32x4*)(yb + CT - 4) = y4; }
            LDS_WAIT(); __syncthreads();
        }
        float* so = A_OUT + O_WKP + ((size_t)bh * 64 + rq * 16 + rl) * 64 + 4 * cg;
        *(f32x4*)so = (f32x4){s01.x, s01.y, s23.x, s23.y};
    } else {
        const float* SW = (const float*)(ws + WS_SW); const bf16* SA = (const bf16*)(ws + WS_SA); const bf16* SB = (const bf16*)(ws + WS_SB); const bf16* SK = (const bf16*)(ws + WS_SK);
        const bf16* SWR = (const bf16*)(ws + WS_SWR); const bf16* SV = (const bf16*)(ws + WS_SV);
        const float* SBR = (const float*)(ws + WS_SBR); const float* SKR = (const float*)(ws + WS_SKR);
        float* YS = A_OUT;
        const int ht = tid - 256, tok = ht >> 3, p8 = ht & 7;
        const size_t g0 = (size_t)bh * SEQ * 64 + (size_t)ht * 8;
#define H_CVT8(dst, u) do { *(LAS f32x4*)(dst) = (f32x4){bflo((u).x), bfhi((u).x), bflo((u).y), bfhi((u).y)}; *(LAS f32x4*)((dst) + 4) = (f32x4){bflo((u).z), bfhi((u).z), bflo((u).w), bfhi((u).w)}; } while (0)
#define H_LOAD(c_) do { const size_t g_ = g0 + (size_t)(c_) * CT * 64; \
        w0_ = *(const f32x4*)(SW + g_); w1_ = *(const f32x4*)(SW + g_ + 4); a_ = *(const v4u*)(SA + g_); b_ = *(const v4u*)(SB + g_); k_ = *(const v4u*)(SK + g_); r_ = *(const v4u*)(SWR + g_); \
        v_ = *(const unsigned*)(SV + ((size_t)bh * SEQ + (c_) * CT + tok) * 64 + rq * 16 + 2 * p8); \
        if (ht < CT) { sc_.x = SBR[(size_t)bh * SEQ + (c_) * CT + ht]; sc_.y = SKR[(size_t)bh * SEQ + (c_) * CT + ht]; } } while (0)
#define H_PUT(B_) do { LAS float* d_ = (B_) + ht * 8; *(LAS f32x4*)d_ = w0_; *(LAS f32x4*)(d_ + 4) = w1_; H_CVT8(d_ + 2048, a_); H_CVT8(d_ + 4096, b_); H_CVT8(d_ + 6144, k_); H_CVT8(d_ + 8192, r_); \
        *(LAS f32x2*)((B_) + 10240 + tok * 16 + 2 * p8) = (f32x2){bflo(v_), bfhi(v_)}; if (ht < CT) *(LAS f32x2*)((B_) + 10752 + ht * 2) = sc_; } while (0)
#define H_YOUT(c_) do { const LAS float* yb_ = ybuf0 + ((c_) & 1) * 512; const f32x2 y_ = {yb_[(2 * p8) * 32 + tok], yb_[(2 * p8 + 1) * 32 + tok]}; \
        *(f32x2*)(YS + ((size_t)b * SEQ + (c_) * CT + tok) * DA + h * 64 + rq * 16 + 2 * p8) = y_; } while (0)
        f32x4 w0_, w1_; v4u a_, b_, k_, r_; unsigned v_; f32x2 sc_ = {0.f, 0.f};
        H_LOAD(0); H_PUT(buf0);
        H_LOAD(1);
        LDS_WAIT(); __syncthreads();
#pragma unroll 1
        for (int c = 0; c < NCH; ++c) {
            if (c + 1 < NCH) H_PUT(buf0 + ((c + 1) & 1) * BUFSZ);
            if (c + 2 < NCH) H_LOAD(c + 2);
            if (c >= 1) H_YOUT(c - 1);
            LDS_WAIT(); __syncthreads();
        }
        H_YOUT(NCH - 1);
#undef H_CVT8
#undef H_LOAD
#undef H_PUT
#undef H_YOUT
    }
    LDS_WAIT(); __syncthreads();
}
constexpr int CLD = 72, CMAT = 64 * CLD;
#define CSLOT(i) ((LAS bf16*)lds + (i) * CMAT)
__device__ __forceinline__ bf16x8 ldf(const LAS bf16* p) { return *(const LAS bf16x8*)p; }
__device__ __forceinline__ bf16x8 ldf(const bf16* p) { return *(const bf16x8*)p; }
template <class PA, class PB> __device__ __forceinline__ f32x4 mm_tile(PA A, int lda, PB Bt, int ldb, int tr, int tc, int fr, int fq, f32x4 acc) {
    PA ap = A + (16 * tr + fr) * lda + 8 * fq; PB bp = Bt + (16 * tc + fr) * ldb + 8 * fq;
    acc = __builtin_amdgcn_mfma_f32_16x16x32_bf16(ldf(ap), ldf(bp), acc, 0, 0, 0);
    acc = __builtin_amdgcn_mfma_f32_16x16x32_bf16(ldf(ap + 32), ldf(bp + 32), acc, 0, 0, 0);
    return acc;
}
__device__ __forceinline__ v2u pack4(const f32x4 v) { return (v2u){pk2(v.x, v.y), pk2(v.z, v.w)}; }
struct ChunkIn { v4u r, k, v, x0, x1, q0, q1, pv; float c[6]; };
__device__ __forceinline__ void chunk_in_load(ChunkIn& x, const PArgs& a, int item, int tid) {
    const bf16* PS = (const bf16*)(A_WS + WS_PS);
    const int bh = item >> 5, c = item & 31, b = bh >> 4, h = bh & 15; const size_t m0 = (size_t)b * SEQ + (size_t)c * 64;
    const bf16* p = PS + (m0 + (tid >> 3)) * PSW + h * 64 + 8 * (tid & 7);
    x.r = *(const v4u*)p; x.k = *(const v4u*)(p + 1024); x.v = *(const v4u*)(p + 2048);
    const bf16* q = PS + (m0 + (tid >> 4)) * PSW + 3072 + 8 * (tid & 15);
    x.x0 = *(const v4u*)q; x.x1 = *(const v4u*)(q + (size_t)32 * PSW);
    x.q1 = *(const v4u*)(q + (size_t)31 * PSW);
    x.q0 = (v4u){0u, 0u, 0u, 0u}; if (c > 0 || tid >= 16) x.q0 = *(const v4u*)(q - PSW);
    x.pv = (v4u){0u, 0u, 0u, 0u};
    if (c > 0 && tid < 24) x.pv = *(const v4u*)(PS + (m0 - 1) * PSW + (tid >> 3) * 1024 + h * 64 + 8 * (tid & 7));
    const int ch = h * 64 + (tid & 63); const float* mu = A_IN(I_MU);
    x.c[0] = mu[ch]; x.c[1] = mu[1024 + ch]; x.c[2] = mu[2048 + ch]; x.c[3] = A_IN(I_KK)[ch]; x.c[4] = A_IN(I_KA)[ch]; x.c[5] = A_IN(I_RK)[ch];
}
struct LoraW { bf16x8 lb[4][2]; float c0[4]; };
__device__ __forceinline__ void lora_load(LoraW& x, const PArgs& a, int item, int tid) {
    const int h = (item >> 5) & 15, mat = tid >> 8, fr = tid & 15, fq = (tid >> 4) & 3;
    const bf16* LT = (const bf16*)(A_WS + (mat ? WS_ALT : WS_WLT)) + (size_t)(h * 64 + fr) * 64 + 8 * fq; const float* cz = mat ? A_IN(I_A0) : A_IN(I_W0);
#pragma unroll
    for (int tc = 0; tc < 4; ++tc) { x.lb[tc][0] = *(const bf16x8*)(LT + (size_t)16 * tc * 64); x.lb[tc][1] = *(const bf16x8*)(LT + (size_t)16 * tc * 64 + 32); x.c0[tc] = cz[h * 64 + 16 * tc + fr]; }
}
__device__ __forceinline__ void chunk_pre(const PArgs& a, LAS unsigned char* lds, int tid, int lane, int wave, int item, const ChunkIn& in, bool dry, LoraW& lw, int item_next) {
    unsigned char* ws = A_WS;
    const size_t base = ((size_t)(item >> 5) * SEQ + (size_t)(item & 31) * 64) * 64;
    float* SWp = (float*)(ws + WS_SW) + base; bf16* SAp = (bf16*)(ws + WS_SA) + base; bf16* SBp = (bf16*)(ws + WS_SB) + base; bf16* SKp = (bf16*)(ws + WS_SK) + base;
    bf16* SRp = (bf16*)(ws + WS_SWR) + base;
    LAS bf16* At = CSLOT(0); LAS bf16* Bt = CSLOT(1); LAS bf16* Kt = CSLOT(2); LAS bf16* Rt = CSLOT(3); LAS bf16* AtT = CSLOT(4); LAS bf16* BtT = CSLOT(5); LAS bf16* KtT = CSLOT(6); LAS bf16* VT = CSLOT(7);
    LAS bf16* Lak = CSLOT(10); LAS bf16* Mrb = CSLOT(11); LAS bf16* Mrk = CSLOT(12);
    LAS float* gC = (LAS float*)(lds + 15 * CMAT * 2);
    const int fr = lane & 15, fq = lane >> 4, tr = wave >> 1, tc0 = 2 * (wave & 1);
    {
        LAS bf16* Rr = CSLOT(8); LAS bf16* Kr = CSLOT(9); LAS bf16* Vr = CSLOT(10); LAS bf16* Aw = CSLOT(0); LAS bf16* Aa = CSLOT(1);
        LAS float* DC = (LAS float*)CSLOT(11); LAS float* AL = (LAS float*)CSLOT(13);
        LAS float* gp = (LAS float*)(lds + 15 * CMAT * 2 + 256); const LAS float* mux = gp + 512;
        const int bh_ = item >> 5, h_ = bh_ & 15;
        {
            const int row = tid >> 3, part = tid & 7;
            *(LAS v4u*)(Rr + (row + 1) * 64 + 8 * part) = in.r; *(LAS v4u*)(Kr + (row + 1) * 64 + 8 * part) = in.k; *(LAS v4u*)(Vr + (row + 1) * 64 + 8 * part) = in.v;
            if (tid < 24) { LAS bf16* d_ = tid < 8 ? Rr : (tid < 16 ? Kr : Vr); *(LAS v4u*)(d_ + 8 * (tid & 7)) = in.pv; }
            const int xr = tid >> 4, cb = (tid & 15) * 8;
            const f32x4 m0_ = *(const LAS f32x4*)(mux + cb), m1_ = *(const LAS f32x4*)(mux + cb + 4);
            const float mm[8] = {m0_.x, m0_.y, m0_.z, m0_.w, m1_.x, m1_.y, m1_.z, m1_.w};
            LAS bf16* dst = cb < 64 ? Aw + xr * CLD + cb : Aa + xr * CLD + (cb - 64);
#pragma unroll
            for (int hf = 0; hf < 2; ++hf) { const v4u cv_ = hf ? in.x1 : in.x0, pv_ = hf ? in.q1 : in.q0;
                const unsigned cw_[4] = {cv_.x, cv_.y, cv_.z, cv_.w}, pw_[4] = {pv_.x, pv_.y, pv_.z, pv_.w}; unsigned ow_[4];
#pragma unroll
                for (int i = 0; i < 4; ++i) { const float ca = bflo(cw_[i]), cbv = bfhi(cw_[i]);
                    float xa_ = ca + mm[2 * i] * (bflo(pw_[i]) - ca), xb_ = cbv + mm[2 * i + 1] * (bfhi(pw_[i]) - cbv);
                    if (cb < 64) { xa_ = tanh_fast(xa_); xb_ = tanh_fast(xb_); }
                    ow_[i] = pk2(xa_, xb_); }
                *(LAS v4u*)(dst + hf * 32 * CLD) = (v4u){ow_[0], ow_[1], ow_[2], ow_[3]}; }
        }
        const int mat = wave >> 2, sr_ = wave & 3;
        LDS_BAR();
        {
            const LAS bf16* Am = (mat ? Aa : Aw) + (16 * sr_ + fr) * CLD + 8 * fq;
            const bf16x8 a0 = ldf(Am), a1 = ldf(Am + 32);
            f32x4 lacc[4];
#pragma unroll
            for (int tc = 0; tc < 4; ++tc) { lacc[tc] = __builtin_amdgcn_mfma_f32_16x16x32_bf16(a0, lw.lb[tc][0], (f32x4){0.f, 0.f, 0.f, 0.f}, 0, 0, 0); lacc[tc] = __builtin_amdgcn_mfma_f32_16x16x32_bf16(a1, lw.lb[tc][1], lacc[tc], 0, 0, 0); }
            LAS float* D_ = mat ? AL : DC;
#pragma unroll
            for (int tc = 0; tc < 4; ++tc)
#pragma unroll
                for (int reg = 0; reg < 4; ++reg) { const float sg_ = sigm(lw.c0[tc] + lacc[tc][reg]); D_[(16 * sr_ + 4 * fq + reg) * 68 + 16 * tc + fr] = mat ? sg_ : __expf(-0.6065306597126334f * sg_); }
        }
        LDS_BAR();
        const int j = lane, t0 = wave * 8;
        float wv[8], al_[8]; unsigned short ur[9], uk[9], uv[9];
#pragma unroll
        for (int i = 0; i < 8; ++i) { wv[i] = DC[(t0 + i) * 68 + j]; al_[i] = AL[(t0 + i) * 68 + j]; }
#pragma unroll
        for (int i = 0; i < 9; ++i) { const int o = (t0 + i) * 64 + j; ur[i] = Rr[o]; uk[i] = Kr[o]; uv[i] = Vr[o]; }
        float pl = wv[0];
#pragma unroll
        for (int i = 1; i < 8; ++i) pl *= wv[i];
        gp[wave * 64 + j] = pl;
        float r_[8], kf_[8], kq_[8], n2_[8], sb_[8]; unsigned xv[4];
        {   float pR = bf1(ur[0]), pK = bf1(uk[0]), pV = bf1(uv[0]);
            bf16* SVp = (bf16*)(ws + WS_SV) + base;
#pragma unroll
            for (int i = 0; i < 8; ++i) { const float cr = bf1(ur[i + 1]), ck = bf1(uk[i + 1]), cv = bf1(uv[i + 1]);
                const float r = cr + in.c[0] * (pR - cr), k = ck + in.c[1] * (pK - ck), v = cv + in.c[2] * (pV - cv);
                pR = cr; pK = ck; pV = cv;
                const float kkr = k * in.c[3], kf = k * (1.0f + (al_[i] - 1.0f) * in.c[4]);
                r_[i] = r; kf_[i] = kf; kq_[i] = kkr; n2_[i] = kkr * kkr; sb_[i] = r * kf * in.c[5];
                const unsigned vb = f2bf(v); if (i & 1) xv[i >> 1] |= vb << 16; else xv[i >> 1] = vb;
                if (!dry) SVp[(t0 + i) * 64 + j] = (bf16)vb; }
#pragma unroll
            for (int i = 0; i < 8; ++i) { n2_[i] = reduce16(n2_[i]); sb_[i] = reduce16(sb_[i]); }
#pragma unroll
            for (int i = 0; i < 8; ++i) { n2_[i] = row_sum4(n2_[i]); sb_[i] = row_sum4(sb_[i]); }
        }
        LDS_BAR();
        float g = 1.f;
#pragma unroll
        for (int q = 0; q < 7; ++q) { const float x = gp[q * 64 + j]; g *= (q < wave) ? x : 1.f; }
        f32x4 xa[2], xb[2], xk[2]; float sbk = 0.f;
#pragma unroll
        for (int i = 0; i < 8; ++i) {
            const int t = t0 + i;
            const float kk = kq_[i] * __builtin_amdgcn_rsqf(fmaxf(n2_[i], 1e-24f));
            sbk = (lane == i) ? sb_[i] : sbk;
            const float gprev = g; g *= wv[i]; const float inv = __builtin_amdgcn_rcpf(g);
            const float av = -kk * gprev, bv = kk * al_[i] * inv, kv = kf_[i] * inv, rv = r_[i] * g;
            At[t * CLD + j] = (bf16)f2bf(av); Bt[t * CLD + j] = (bf16)f2bf(bv); Kt[t * CLD + j] = (bf16)f2bf(kv); Rt[t * CLD + j] = (bf16)f2bf(rv);
            xa[i >> 2][i & 3] = av; xb[i >> 2][i & 3] = bv; xk[i >> 2][i & 3] = kv;
        }
        if (!dry && lane < 8) ((float*)(ws + WS_SBS))[(size_t)bh_ * SEQ + (size_t)(item & 31) * 64 + t0 + lane] = sbk;
        const v2u a0 = pack4(xa[0]), a1 = pack4(xa[1]), b0 = pack4(xb[0]), b1 = pack4(xb[1]), k0 = pack4(xk[0]), k1 = pack4(xk[1]);
        *(LAS v4u*)(AtT + j * CLD + t0) = (v4u){a0.x, a0.y, a1.x, a1.y}; *(LAS v4u*)(BtT + j * CLD + t0) = (v4u){b0.x, b0.y, b1.x, b1.y};
        *(LAS v4u*)(KtT + j * CLD + t0) = (v4u){k0.x, k0.y, k1.x, k1.y}; *(LAS v4u*)(VT + j * CLD + t0) = (v4u){xv[0], xv[1], xv[2], xv[3]};
        if (wave == 7) gC[j] = g;
    }
    LDS_BAR();
    const f32x4 Z4 = {0.f, 0.f, 0.f, 0.f};
    const int sr = wave & 3, sg = wave >> 2, tb = 16 * sr + 4 * fq;
#define STRIP(acc_, A_, B_) do { int oa_ = (16 * sr + fr) * CLD + 8 * fq, ob_ = fr * CLD + 8 * fq; asm volatile("" : "+v"(oa_), "+v"(ob_)); \
        const bf16x8 a0_ = ldf((A_) + oa_), a1_ = ldf((A_) + oa_ + 32); \
        _Pragma("unroll") for (int tc_ = 0; tc_ < 4; ++tc_) { const LAS bf16* bp_ = (B_) + ob_ + 16 * tc_ * CLD; \
            acc_[tc_] = __builtin_amdgcn_mfma_f32_16x16x32_bf16(a0_, ldf(bp_), acc_[tc_], 0, 0, 0); acc_[tc_] = __builtin_amdgcn_mfma_f32_16x16x32_bf16(a1_, ldf(bp_ + 32), acc_[tc_], 0, 0, 0); } } while (0)
#define STRIP2(acc1_, acc2_, A1_, A2_, B_) do { int oa_ = (16 * sr + fr) * CLD + 8 * fq, ob_ = fr * CLD + 8 * fq; asm volatile("" : "+v"(oa_), "+v"(ob_)); \
        const bf16x8 a0_ = ldf((A1_) + oa_), a1_ = ldf((A1_) + oa_ + 32), a2_ = ldf((A2_) + oa_), a3_ = ldf((A2_) + oa_ + 32); \
        _Pragma("unroll") for (int tc_ = 0; tc_ < 4; ++tc_) { const LAS bf16* bp_ = (B_) + ob_ + 16 * tc_ * CLD; const bf16x8 b0_ = ldf(bp_), b1_ = ldf(bp_ + 32); \
            acc1_[tc_] = __builtin_amdgcn_mfma_f32_16x16x32_bf16(a0_, b0_, acc1_[tc_], 0, 0, 0); acc1_[tc_] = __builtin_amdgcn_mfma_f32_16x16x32_bf16(a1_, b1_, acc1_[tc_], 0, 0, 0); \
            acc2_[tc_] = __builtin_amdgcn_mfma_f32_16x16x32_bf16(a2_, b0_, acc2_[tc_], 0, 0, 0); acc2_[tc_] = __builtin_amdgcn_mfma_f32_16x16x32_bf16(a3_, b1_, acc2_[tc_], 0, 0, 0); } } while (0)
    LAS bf16* Xc = CSLOT(8); LAS bf16* XTc = CSLOT(9); LAS bf16* TTc = CSLOT(13);
    int ow = tb * CLD + fr, ot = fr * CLD + tb;
#define OPQ() asm volatile("" : "+v"(ow), "+v"(ot))
    OPQ();
    {
        if (sg == 0) {
            f32x4 c1[4] = {Z4, Z4, Z4, Z4}, c2[4] = {Z4, Z4, Z4, Z4}, c3[4] = {Z4, Z4, Z4, Z4};
            STRIP(c1, At, Bt); STRIP2(c2, c3, Bt, Kt, At);
#pragma unroll
            for (int tc = 0; tc < 4; ++tc) { const int c = 16 * tc + fr; f32x4 x, t1, xr, lk;
#pragma unroll
                for (int reg = 0; reg < 4; ++reg) { const int r = tb + reg; x[reg] = c < r ? c1[tc][reg] : 0.f; t1[reg] = x[reg] + (c == r ? 1.f : 0.f); xr[reg] = r < c ? c2[tc][reg] : 0.f; lk[reg] = r < c ? c3[tc][reg] : 0.f; }
                *(LAS v2u*)(XTc + ot + 16 * tc * CLD) = pack4(x); *(LAS v2u*)(TTc + ot + 16 * tc * CLD) = pack4(t1);
                *(LAS v2u*)(Xc + ot + 16 * tc * CLD) = pack4(xr); *(LAS v2u*)(Lak + ot + 16 * tc * CLD) = pack4(lk); }
        } else {
            f32x4 c4[4] = {Z4, Z4, Z4, Z4}, c5[4] = {Z4, Z4, Z4, Z4};
            STRIP2(c4, c5, Bt, Kt, Rt);
#pragma unroll
            for (int tc = 0; tc < 4; ++tc) { const int c = 16 * tc + fr; f32x4 mb, mk;
#pragma unroll
                for (int reg = 0; reg < 4; ++reg) { const int r = tb + reg; mb[reg] = r <= c ? c4[tc][reg] : 0.f; mk[reg] = r <= c ? c5[tc][reg] : 0.f; }
                *(LAS v2u*)(Mrb + ot + 16 * tc * CLD) = pack4(mb); *(LAS v2u*)(Mrk + ot + 16 * tc * CLD) = pack4(mk); }
        }
    }
    LDS_BAR(); OPQ();
    LAS bf16* Xn = CSLOT(1); LAS bf16* XTn = CSLOT(2); LAS bf16* TTn = CSLOT(0);
    LAS bf16* W2T = CSLOT(14);
    {   f32x4 r_[4] = {Z4, Z4, Z4, Z4};
        if (sg == 0) { f32x4 q_[4] = {Z4, Z4, Z4, Z4};
            STRIP(r_, Xc, XTc); STRIP(q_, XTc, Xc);
#pragma unroll
            for (int tc = 0; tc < 4; ++tc) { *(LAS v2u*)(XTn + ot + 16 * tc * CLD) = pack4(r_[tc]); *(LAS v2u*)(Xn + ot + 16 * tc * CLD) = pack4(q_[tc]); }
        } else { STRIP(r_, Lak, VT);
#pragma unroll
            for (int tc = 0; tc < 4; ++tc) *(LAS v2u*)(W2T + ot + 16 * tc * CLD) = pack4(r_[tc]); }
    }
    LDS_BAR(); OPQ();
    { LAS bf16* t_ = Xc; Xc = Xn; Xn = t_; t_ = XTc; XTc = XTn; XTn = t_; }
#pragma unroll
    for (int it = 1; it <= 4; ++it) {
        f32x4 r_[4] = {Z4, Z4, Z4, Z4};
        if (sg == 0) { STRIP(r_, Xc, TTc);
#pragma unroll
            for (int tc = 0; tc < 4; ++tc) { const v2u told = *(const LAS v2u*)(TTc + ot + 16 * tc * CLD); f32x4 y = r_[tc];
                y[0] += bflo(told.x); y[1] += bfhi(told.x); y[2] += bflo(told.y); y[3] += bfhi(told.y);
                *(LAS v2u*)(TTn + ot + 16 * tc * CLD) = pack4(y); }
        } else { f32x4 q_[4] = {Z4, Z4, Z4, Z4};
            STRIP(r_, Xc, XTc); STRIP(q_, XTc, Xc);
#pragma unroll
            for (int tc = 0; tc < 4; ++tc) { *(LAS v2u*)(XTn + ot + 16 * tc * CLD) = pack4(r_[tc]); *(LAS v2u*)(Xn + ot + 16 * tc * CLD) = pack4(q_[tc]); }
        }
        LDS_BAR(); OPQ();
        { LAS bf16* t_ = Xc; Xc = Xn; Xn = t_; t_ = XTc; XTc = XTn; XTn = t_; t_ = TTc; TTc = TTn; TTn = t_; }
    }
    LAS bf16* Trm = CSLOT(10);
    {   const bf16x8 a0 = ldf(TTc + (16 * sr + fr) * CLD + 8 * fq), a1 = ldf(TTc + (16 * sr + fr) * CLD + 8 * fq + 32);
#pragma unroll
        for (int ti = 0; ti < 2; ++ti) { const int tc = 2 * sg + ti; const LAS bf16* bp = Xc + (16 * tc + fr) * CLD + 8 * fq;
            f32x4 y = __builtin_amdgcn_mfma_f32_16x16x32_bf16(a0, ldf(bp), Z4, 0, 0, 0); y = __builtin_amdgcn_mfma_f32_16x16x32_bf16(a1, ldf(bp + 32), y, 0, 0, 0);
#pragma unroll
            for (int reg = 0; reg < 4; ++reg) y[reg] += bf1(TTc[ow + reg * CLD + 16 * tc]);
            *(LAS v2u*)(Trm + ot + 16 * tc * CLD) = pack4(y); }
    }
    LDS_BAR(); OPQ();
    LAS bf16* G1T = Xn; LAS bf16* G2T = XTn;
    {   f32x4 r_[4] = {Z4, Z4, Z4, Z4};
        if (sg == 0) STRIP(r_, Trm, AtT); else STRIP(r_, Trm, W2T);
        LAS bf16* dst = sg == 0 ? G1T : G2T;
#pragma unroll
        for (int tc = 0; tc < 4; ++tc) *(LAS v2u*)(dst + ot + 16 * tc * CLD) = pack4(r_[tc]);
    }
    LDS_BAR(); OPQ();
    {
        LAS bf16* oPh = CSLOT(0); LAS bf16* oQ = CSLOT(2); LAS bf16* oRy = CSLOT(4); LAS bf16* oY0 = CSLOT(1);
        f32x4 u_[4] = {Z4, Z4, Z4, Z4}, v_[4] = {Z4, Z4, Z4, Z4};
        if (sg == 0) { STRIP(u_, G1T, BtT); STRIP(v_, BtT, G2T); STRIP(v_, KtT, VT); } else { STRIP(u_, G1T, Mrb); STRIP(v_, Mrb, G2T); STRIP(v_, Mrk, VT); }
#pragma unroll
        for (int tc = 0; tc < 4; ++tc) { const int c = 16 * tc + fr, fo = ((2 * sr + (tc >> 1)) * 64 + lane) * 8 + (tc & 1) * 4;
            if (sg == 0) { f32x4 qv, pv; const float gcc = gC[c];
#pragma unroll
                for (int reg = 0; reg < 4; ++reg) { const int r = tb + reg; pv[reg] = gcc * (u_[tc][reg] + (c == r ? 1.f : 0.f)); qv[reg] = gC[r] * v_[tc][reg]; }
                *(LAS v2u*)(oPh + ot + 16 * tc * CLD) = pack4(pv);
                *(LAS v2u*)(oQ + fo) = pack4(qv);
            } else { const v2u rt = *(const LAS v2u*)(Rt + ot + 16 * tc * CLD); f32x4 y = u_[tc];
                y[0] += bflo(rt.x); y[1] += bfhi(rt.x); y[2] += bflo(rt.y); y[3] += bfhi(rt.y);
                *(LAS v2u*)(oRy + ot + 16 * tc * CLD) = pack4(y);
                *(LAS v2u*)(oY0 + fo) = pack4(v_[tc]); }
        }
#undef STRIP
#undef STRIP2
#undef OPQ
        LDS_BAR();
        lora_load(lw, a, item_next, tid);
        const int e = tid * 8, ep = (tid >> 3) * CLD + (tid & 7) * 8;
        if (!dry) {
        *(v4u*)(SAp + e) = *(const LAS v4u*)(oPh + ep); *(v4u*)(SBp + e) = *(const LAS v4u*)(oY0 + e); *(v4u*)(SKp + e) = *(const LAS v4u*)(oQ + e); *(v4u*)(SRp + e) = *(const LAS v4u*)(oRy + ep); }
    }
    LDS_BAR();
}
struct ChainOps { bf16x8 ry[2], ph[2]; v4u y0, q; };
__device__ __forceinline__ void chain_load(ChainOps& o, const unsigned char* ws, size_t base, int tr, int tc0, int fr, int fq) {
    const bf16* Y0 = (const bf16*)(ws + WS_SB) + base; const bf16* Ph = (const bf16*)(ws + WS_SA) + base;
    const bf16* Qb = (const bf16*)(ws + WS_SK) + base; const bf16* Ry = (const bf16*)(ws + WS_SWR) + base;
    const int ao = (16 * tr + fr) * 64 + 8 * fq;
#pragma unroll
    for (int ks = 0; ks < 2; ++ks) { o.ry[ks] = *(const bf16x8*)(Ry + ao + 32 * ks); o.ph[ks] = *(const bf16x8*)(Ph + ao + 32 * ks); }
    const int fo = ((2 * tr + (tc0 >> 1)) * 64 + fq * 16 + fr) * 8;
    o.y0 = *(const v4u*)(Y0 + fo); o.q = *(const v4u*)(Qb + fo);
}
__device__ __forceinline__ void chunk_chain(const PArgs& a, LAS unsigned char* lds, int tid, int lane, int wave, int bh, bool probe_same) {
    unsigned char* ws = A_WS; bf16* YS = (bf16*)A_OUT;
    LAS bf16* HhT = CSLOT(0); LAS bf16* HlT = CSLOT(1); LAS bf16* ybuf = CSLOT(2);
    for (int i = tid; i < 2 * CMAT / 2; i += NTHR) ((LAS unsigned*)HhT)[i] = 0u;
    const int fr = lane & 15, fq = lane >> 4, tr = wave >> 1, tc0 = 2 * (wave & 1), b = bh >> 4, h = bh & 15;
    const f32x4 Z4 = {0.f, 0.f, 0.f, 0.f};
    f32x4 hn[2] = {Z4, Z4};
    constexpr int NC = SEQ / 64;
    const size_t hb = (size_t)bh * SEQ * 64;
    auto step = [&](const ChainOps& cur, int c) {
#pragma unroll
        for (int ti = 0; ti < 2; ++ti) { const int s = 16 * (tc0 + ti) + fr, tb = 16 * tr + 4 * fq;
            const LAS bf16* hp = HhT + s * CLD + 8 * fq; const LAS bf16* lp = HlT + s * CLD + 8 * fq;
            const bf16x8 hh0 = ldf(hp), hh1 = ldf(hp + 32), hl0 = ldf(lp), hl1 = ldf(lp + 32);
            f32x4 yy = __builtin_amdgcn_mfma_f32_16x16x32_bf16(cur.ry[0], hh0, Z4, 0, 0, 0); yy = __builtin_amdgcn_mfma_f32_16x16x32_bf16(cur.ry[1], hh1, yy, 0, 0, 0);
            yy = __builtin_amdgcn_mfma_f32_16x16x32_bf16(cur.ry[0], hl0, yy, 0, 0, 0); yy = __builtin_amdgcn_mfma_f32_16x16x32_bf16(cur.ry[1], hl1, yy, 0, 0, 0);
            f32x4 hh = __builtin_amdgcn_mfma_f32_16x16x32_bf16(cur.ph[0], hh0, Z4, 0, 0, 0); hh = __builtin_amdgcn_mfma_f32_16x16x32_bf16(cur.ph[1], hh1, hh, 0, 0, 0);
            hh = __builtin_amdgcn_mfma_f32_16x16x32_bf16(cur.ph[0], hl0, hh, 0, 0, 0); hh = __builtin_amdgcn_mfma_f32_16x16x32_bf16(cur.ph[1], hl1, hh, 0, 0, 0);
#pragma unroll
            for (int reg = 0; reg < 4; ++reg) { const int t = tb + reg;
                const unsigned yw = cur.y0[ti * 2 + (reg >> 1)], qw = cur.q[ti * 2 + (reg >> 1)];
                ybuf[t * CLD + s] = (bf16)f2bf(yy[reg] + ((reg & 1) ? bfhi(yw) : bflo(yw)));
                hn[ti][reg] = hh[reg] + ((reg & 1) ? bfhi(qw) : bflo(qw)); }
        }
        LDS_BAR();
#pragma unroll
        for (int ti = 0; ti < 2; ++ti) { const int s = 16 * (tc0 + ti) + fr, tb = 16 * tr + 4 * fq;
            f32x4 hi, lo;
#pragma unroll
            for (int reg = 0; reg < 4; ++reg) { hi[reg] = __uint_as_float(f2bf(hn[ti][reg]) << 16); lo[reg] = hn[ti][reg] - hi[reg]; }
            *(LAS v2u*)(HhT + s * CLD + tb) = pack4(hi); *(LAS v2u*)(HlT + s * CLD + tb) = pack4(lo); }
        *(v4u*)(YS + ((size_t)b * SEQ + c * 64 + (tid >> 3)) * DA + h * 64 + 8 * (tid & 7)) = *(const LAS v4u*)(ybuf + (tid >> 3) * CLD + 8 * (tid & 7));
        LDS_BAR();
    };
    auto cbase = [&](int c) { return hb + (size_t)(probe_same ? 0 : (c < NC ? c : NC - 1)) * 4096; };
    ChainOps o0, o1, o2;
    chain_load(o0, ws, cbase(0), tr, tc0, fr, fq); chain_load(o1, ws, cbase(1), tr, tc0, fr, fq);
    LDS_BAR();
#pragma unroll
    for (int c = 0; c < NC; c += 3) {
        chain_load(o2, ws, cbase(c + 2), tr, tc0, fr, fq); step(o0, c);
        chain_load(o0, ws, cbase(c + 3), tr, tc0, fr, fq); if (c + 1 < NC) step(o1, c + 1);
        chain_load(o1, ws, cbase(c + 4), tr, tc0, fr, fq); if (c + 2 < NC) step(o2, c + 2);
    }
#pragma unroll
    for (int ti = 0; ti < 2; ++ti) { const int s = 16 * (tc0 + ti) + fr, tb = 16 * tr + 4 * fq;
#pragma unroll
        for (int reg = 0; reg < 4; ++reg) A_OUT[O_WKP + ((size_t)bh * 64 + s) * 64 + tb + reg] = hn[ti][reg]; }
    LDS_BAR();
}
__device__ __forceinline__ void oa_token(const PArgs& a, int lane, int m) {
    unsigned char* ws = A_WS; const bf16* YS = (const bf16*)A_OUT; const bf16* SV = (const bf16*)(ws + WS_SV); const float* SBS = (const float*)(ws + WS_SBS);
    const bf16* GA = (const bf16*)(ws + WS_GA); bf16* OA = (bf16*)(ws + WS_OA);
    const int b = m / SEQ, t = m & (SEQ - 1);
#pragma unroll
    for (int q = 0; q < 4; ++q) {
        const int c = 4 * lane + 256 * q, hd = c >> 6, i4 = c & 63; const size_t tix = (size_t)(b * NH + hd) * SEQ + t;
        const v2u yc = *(const v2u*)(YS + (size_t)m * DA + c); const f32x4 y4 = {bflo(yc.x), bfhi(yc.x), bflo(yc.y), bfhi(yc.y)};
        const float mean = reduce16((y4.x + y4.y) + (y4.z + y4.w)) * (1.0f / 64.0f);
        const f32x4 d = y4 - mean;
        const float var = reduce16((d.x * d.x + d.y * d.y) + (d.z * d.z + d.w * d.w)) * (1.0f / 64.0f);
        const float rstd = 1.0f / sqrtf(var + GN_EPS), bs = SBS[tix];
        const v2u vc = *(const v2u*)(SV + tix * 64 + i4), gc = *(const v2u*)(GA + (size_t)m * DA + c);
        const f32x4 v4 = {bflo(vc.x), bfhi(vc.x), bflo(vc.y), bfhi(vc.y)}, g = {bflo(gc.x), bfhi(gc.x), bflo(gc.y), bfhi(gc.y)};
        const f32x4 lng = *(const f32x4*)(A_IN(I_LNXG) + c), lnb = *(const f32x4*)(A_IN(I_LNXB) + c);
        f32x4 o = d * rstd * lng + lnb + bs * v4;
        o.x *= g.x * sigm(g.x); o.y *= g.y * sigm(g.y); o.z *= g.z * sigm(g.z); o.w *= g.w * sigm(g.w);
        *(v2u*)(OA + (size_t)m * OAS + c) = (v2u){pk2(o.x, o.y), pk2(o.z, o.w)};
    }
}
__device__ __forceinline__ void sample_wkv_item(const PArgs& a, LAS float* wscr, int lane, int item) {
    unsigned char* ws = A_WS;
    const bf16* PS = (const bf16*)(ws + WS_PS); const bf16* WlT = (const bf16*)(ws + WS_WLT); const bf16* AlT = (const bf16*)(ws + WS_ALT);
    const bf16* GA = (const bf16*)(ws + WS_GA); bf16* OA = (bf16*)(ws + WS_OA);
    const float* mu = A_IN(I_MU); const float* sst = A_IN(I_SSHIFT);
    const int s = item >> 4, h = item & 15, cg = lane & 15, rp = lane >> 4, ch = h * 64 + lane; const size_t m = (size_t)MP + s;
    const float* S0 = A_IN(I_SWKV) + (size_t)item * 4096; float* S1 = A_OUT + O_WKS + (size_t)item * 4096;
    f32x4 st0[8], st1[8];
#pragma unroll
    for (int ps = 0; ps < 8; ++ps) { const int i0 = ps * 8 + 2 * rp;
        st0[ps] = *(const f32x4*)(S0 + (size_t)i0 * 64 + 4 * cg); st1[ps] = *(const f32x4*)(S0 + (size_t)(i0 + 1) * 64 + 4 * cg); }
    LAS float* xw = wscr; LAS float* xa = wscr + 64; LAS float* tv = wscr + 128;
    { const bf16* pr = PS + m * PSW + 3072 + lane; const float* sr = sst + (size_t)s * SHW + 3072 + lane;
      const float p0 = bf1(pr[0]), p1 = bf1(pr[64]), q0 = sr[0], q1 = sr[64], m0 = mu[3072 + lane], m1 = mu[3136 + lane];
      xw[lane] = tanh_fast(p0 + m0 * (q0 - p0)); xa[lane] = p1 + m1 * (q1 - p1); }
    v4u wl[8], al_[8];
#pragma unroll
    for (int i = 0; i < 8; ++i) { wl[i] = *(const v4u*)(WlT + (size_t)ch * 64 + 8 * i); al_[i] = *(const v4u*)(AlT + (size_t)ch * 64 + 8 * i); }
    const bf16* pr = PS + m * PSW + ch; const float* sr = sst + (size_t)s * SHW + ch;
    const float pR = bf1(pr[0]), pK = bf1(pr[1024]), pV = bf1(pr[2048]), qR = sr[0], qK = sr[1024], qV = sr[2048];
    const float r = pR + mu[ch] * (qR - pR), k = pK + mu[1024 + ch] * (qK - pK), v = pV + mu[2048 + ch] * (qV - pV);
    const float cW0 = A_IN(I_W0)[ch], cA0 = A_IN(I_A0)[ch], cKK = A_IN(I_KK)[ch], cKA = A_IN(I_KA)[ch], cRK = A_IN(I_RK)[ch], cLG = A_IN(I_LNXG)[ch], cLB = A_IN(I_LNXB)[ch], g = bf1(GA[m * DA + ch]);
    LDS_WAIT(); __builtin_amdgcn_wave_barrier(); asm volatile("" ::: "memory");
    float lw = 0.f, la = 0.f;
#pragma unroll
    for (int i = 0; i < 8; ++i) { const f32x4 x0 = *(const LAS f32x4*)(xw + 8 * i), x1 = *(const LAS f32x4*)(xw + 8 * i + 4), y0 = *(const LAS f32x4*)(xa + 8 * i), y1 = *(const LAS f32x4*)(xa + 8 * i + 4);
        lw += (bflo(wl[i].x) * x0.x + bfhi(wl[i].x) * x0.y) + (bflo(wl[i].y) * x0.z + bfhi(wl[i].y) * x0.w) + (bflo(wl[i].z) * x1.x + bfhi(wl[i].z) * x1.y) + (bflo(wl[i].w) * x1.z + bfhi(wl[i].w) * x1.w);
        la += (bflo(al_[i].x) * y0.x + bfhi(al_[i].x) * y0.y) + (bflo(al_[i].y) * y0.z + bfhi(al_[i].y) * y0.w) + (bflo(al_[i].z) * y1.x + bfhi(al_[i].z) * y1.y) + (bflo(al_[i].w) * y1.z + bfhi(al_[i].w) * y1.w); }
    const float dc = __expf(-0.6065306597126334f * sigm(cW0 + lw)), al = sigm(cA0 + la);
    const float kkr = k * cKK, kf = k * (1.0f + (al - 1.0f) * cKA);
    const float inv = 1.0f / fmaxf(sqrtf(wave_sum(kkr * kkr)), 1e-12f), kk = kkr * inv;
    const float br = wave_sum(kk * al * r), kr = wave_sum(kf * r), bs = wave_sum(r * kf * cRK);
    tv[lane] = dc; tv[64 + lane] = -kk; tv[128 + lane] = kk * al; tv[192 + lane] = kf; tv[256 + lane] = dc * r; tv[320 + lane] = v;
    LDS_WAIT(); __builtin_amdgcn_wave_barrier(); asm volatile("" ::: "memory");
    const f32x4 w4 = *(const LAS f32x4*)(tv + 4 * cg), a4 = *(const LAS f32x4*)(tv + 64 + 4 * cg), b4 = *(const LAS f32x4*)(tv + 128 + 4 * cg), k4 = *(const LAS f32x4*)(tv + 192 + 4 * cg),
                wr4 = *(const LAS f32x4*)(tv + 256 + 4 * cg);
    LAS float* yb = tv + 384;
#pragma unroll
    for (int ps = 0; ps < 8; ++ps) {
        const int i0 = ps * 8 + 2 * rp;
        f32x4 s0 = st0[ps], s1 = st1[ps];
        const f32x2 vv = *(const LAS f32x2*)(tv + 320 + i0); const float v0 = vv.x, v1 = vv.y;
        float d00 = 0.f, d01 = 0.f, d10 = 0.f, d11 = 0.f;
#pragma unroll
        for (int e = 0; e < 4; ++e) { d00 += s0[e] * a4[e]; d01 += s0[e] * wr4[e]; d10 += s1[e] * a4[e]; d11 += s1[e] * wr4[e]; }
        d00 = reduce16(d00); d01 = reduce16(d01); d10 = reduce16(d10); d11 = reduce16(d11);
        const float y0 = d01 + d00 * br + v0 * kr, y1 = d11 + d10 * br + v1 * kr;
#pragma unroll
        for (int e = 0; e < 4; ++e) { s0[e] = s0[e] * w4[e] + (d00 * b4[e] + v0 * k4[e]); s1[e] = s1[e] * w4[e] + (d10 * b4[e] + v1 * k4[e]); }
        *(f32x4*)(S1 + (size_t)i0 * 64 + 4 * cg) = s0; *(f32x4*)(S1 + (size_t)(i0 + 1) * 64 + 4 * cg) = s1;
        if (cg == 0) *(LAS f32x2*)(yb + i0) = (f32x2){y0, y1};
    }
    LDS_WAIT(); __builtin_amdgcn_wave_barrier(); asm volatile("" ::: "memory");
    const float y = yb[lane];
    const float mean = wave_sum(y) * (1.0f / 64.0f), d = y - mean, var = wave_sum(d * d) * (1.0f / 64.0f), rstd = 1.0f / sqrtf(var + GN_EPS);
    float o = d * rstd * cLG + cLB + bs * v;
    o *= g * sigm(g);
    OA[m * OAS + ch] = (bf16)f2bf(o);
    LDS_WAIT(); __builtin_amdgcn_wave_barrier(); asm volatile("" ::: "memory");
}
template <int TPW> struct ConvTailOps { f32x4 g[4], bb[4]; v2u gc[TPW][4]; };
template <int TPW> __device__ __forceinline__ void conv_tail_load(ConvTailOps<TPW>& P, const PArgs& a, int lane, int wave, int mrow0) {
    const bf16* GB = (const bf16*)(A_WS + WS_GB); const float* cg_ = A_IN(I_CLNG); const float* cb_ = A_IN(I_CLNB);
#pragma unroll
    for (int q = 0; q < 4; ++q) { const int ch = 4 * lane + 256 * q; P.g[q] = *(const f32x4*)(cg_ + ch); P.bb[q] = *(const f32x4*)(cb_ + ch);
#pragma unroll
        for (int oo = 0; oo < TPW; ++oo) P.gc[oo][q] = *(const v2u*)(GB + ((size_t)mrow0 + wave * TPW + oo) * DA + ch); }
}
template <int TPW> __device__ __forceinline__ void conv_tail(const ConvTailOps<TPW>& P, const PArgs& a, LAS float* cbuf, int lane, int wave, int mrow0) {
    bf16* CB = (bf16*)(A_WS + WS_CB);
#pragma unroll
    for (int oo = 0; oo < TPW; ++oo) {
        const int o = wave * TPW + oo; const size_t m = (size_t)mrow0 + o;
        f32x4 c[4]; float s = 0.f;
#pragma unroll
        for (int q = 0; q < 4; ++q) { c[q] = *(const LAS f32x4*)(cbuf + o * 1024 + 4 * lane + 256 * q); s += (c[q].x + c[q].y) + (c[q].z + c[q].w); }
        const float mean = wave_sum(s) * (1.0f / 1024.0f); float s2 = 0.f;
#pragma unroll
        for (int q = 0; q < 4; ++q) { c[q] = c[q] - mean; s2 += (c[q].x * c[q].x + c[q].y * c[q].y) + (c[q].z * c[q].z + c[q].w * c[q].w); }
        const float rstd = 1.0f / sqrtf(wave_sum(s2) * (1.0f / 1024.0f) + LN_EPS);
#pragma unroll
        for (int q = 0; q < 4; ++q) { const int ch = 4 * lane + 256 * q; const v2u gc = P.gc[oo][q];
            const f32x4 gb = {bflo(gc.x), bfhi(gc.x), bflo(gc.y), bfhi(gc.y)};
            f32x4 y = c[q] * rstd * P.g[q] + P.bb[q];
            y.x = silu2(y.x, gb.x); y.y = silu2(y.y, gb.y); y.z = silu2(y.z, gb.z); y.w = silu2(y.w, gb.w);
            *(v2u*)(CB + m * OAS + ch) = (v2u){pk2(y.x, y.y), pk2(y.z, y.w)}; }
    }
}
__device__ __forceinline__ void conv_prompt_item(const PArgs& a, LAS unsigned char* lds, int tid, int lane, int wave, int item) {
    unsigned char* ws = A_WS; const bf16* GLU = (const bf16*)(ws + WS_GLU);
    LAS float* cbuf = (LAS float*)lds;
    constexpr int CT = 32, NR = CT + CK - 1, NBAT = 2, RB = (NR + NBAT - 1) / NBAT;
    const int b = item >> 6, t0 = (item & 63) * CT, c0 = 2 * tid;
    const float* cw = A_IN(I_CONVW) + c0;
    f32x2 w[CK];
#pragma unroll
    for (int j = 0; j < CK; ++j) w[j] = *(const f32x2*)(cw + (size_t)j * DA);
    const f32x2 bias = *(const f32x2*)(A_IN(I_CONVB) + c0);
    f32x2 acc[CT];
#pragma unroll
    for (int o = 0; o < CT; ++o) acc[o] = bias;
    const bf16* gbase = GLU + (size_t)b * SEQ * 1024 + c0;
    float* ncv = A_OUT + O_CVP + (size_t)b * 30 * DA + c0;
#pragma unroll
    for (int hb = 0; hb < NBAT; ++hb) {
        unsigned av[RB];
#pragma unroll
        for (int i = 0; i < RB; ++i) { const int p = hb * RB + i, t = t0 - 30 + p; if (p < NR) av[i] = *(const unsigned*)(gbase + (size_t)(t < 0 ? 0 : t) * 1024); }
#pragma unroll
        for (int i = 0; i < RB; ++i) {
            const int p = hb * RB + i, t = t0 - 30 + p;
            if (p < NR) {
                f32x2 u = {bflo(av[i]), bfhi(av[i])};
                if (t < 0) u = (f32x2){0.f, 0.f};
                if (t0 == SEQ - CT && p >= CT) *(f32x2*)(ncv + (size_t)(p - CT) * DA) = u;
#pragma unroll
                for (int j = 0; j < CK; ++j) { const int o = p - j; if (o >= 0 && o < CT) acc[o] += w[j] * u; }
            }
        }
    }
#pragma unroll
    for (int o = 0; o < CT; ++o) *(LAS f32x2*)(cbuf + o * 1024 + c0) = acc[o];
    ConvTailOps<CT / NWAVES> tl; conv_tail_load<CT / NWAVES>(tl, a, lane, wave, b * SEQ + t0);
    LDS_BAR();
    conv_tail<CT / NWAVES>(tl, a, cbuf, lane, wave, b * SEQ + t0);
    LDS_WAIT(); __syncthreads();
}
__device__ __forceinline__ void conv_sample_wg(const PArgs& a, LAS float* st_, int lane, int wave, int item) {
    unsigned char* ws = A_WS; const bf16* GLU = (const bf16*)(ws + WS_GLU); const bf16* GB = (const bf16*)(ws + WS_GB); bf16* CB = (bf16*)(ws + WS_CB);
    const int sidx = 2 * item + (wave >> 2), ch = 4 * lane + 256 * (wave & 3);
    const float* cw = A_IN(I_CONVW) + ch; const float* st = A_IN(I_SCONV) + (size_t)sidx * 30 * DA + ch; float* no = A_OUT + O_CVS + (size_t)sidx * 30 * DA + ch;
    const size_t m = (size_t)MP + sidx;
    f32x4 acc = *(const f32x4*)(A_IN(I_CONVB) + ch);
#pragma unroll 1
    for (int hf = 0; hf < 2; ++hf) {
        f32x4 x[15], w[15];
#pragma unroll
        for (int i = 0; i < 15; ++i) { const int j = hf * 15 + i; x[i] = *(const f32x4*)(st + (size_t)j * DA); w[i] = *(const f32x4*)(cw + (size_t)j * DA); }
#pragma unroll
        for (int i = 0; i < 15; ++i) { const int j = hf * 15 + i; acc += w[i] * x[i]; if (j >= 1) *(f32x4*)(no + (size_t)(j - 1) * DA) = x[i]; }
    }
    const v2u av = *(const v2u*)(GLU + m * 1024 + ch);
    const f32x4 u = {bflo(av.x), bfhi(av.x), bflo(av.y), bfhi(av.y)};
    acc += *(const f32x4*)(cw + (size_t)30 * DA) * u; *(f32x4*)(no + (size_t)29 * DA) = u;
    const float s1 = wave_sum((acc.x + acc.y) + (acc.z + acc.w)), s2 = wave_sum((acc.x * acc.x + acc.y * acc.y) + (acc.z * acc.z + acc.w * acc.w));
    if (lane == 0) { st_[wave * 2] = s1; st_[wave * 2 + 1] = s2; }
    LDS_WAIT(); __syncthreads();
    const int w0 = (wave >> 2) * 4;
    const float t1 = (st_[w0 * 2] + st_[w0 * 2 + 2]) + (st_[w0 * 2 + 4] + st_[w0 * 2 + 6]), t2 = (st_[w0 * 2 + 1] + st_[w0 * 2 + 3]) + (st_[w0 * 2 + 5] + st_[w0 * 2 + 7]);
    const float mean = t1 * (1.0f / 1024.0f), rstd = 1.0f / sqrtf(fmaxf(t2 * (1.0f / 1024.0f) - mean * mean, 0.f) + LN_EPS);
    const f32x4 g = *(const f32x4*)(A_IN(I_CLNG) + ch), bb = *(const f32x4*)(A_IN(I_CLNB) + ch); const v2u gc = *(const v2u*)(GB + m * DA + ch);
    const f32x4 gb = {bflo(gc.x), bfhi(gc.x), bflo(gc.y), bfhi(gc.y)};
    f32x4 y = (acc - mean) * rstd * g + bb;
    y.x = (y.x * sigm(y.x)) * (gb.x * sigm(gb.x)); y.y = (y.y * sigm(y.y)) * (gb.y * sigm(gb.y)); y.z = (y.z * sigm(y.z)) * (gb.z * sigm(gb.z)); y.w = (y.w * sigm(y.w)) * (gb.w * sigm(gb.w));
    *(v2u*)(CB + m * OAS + ch) = (v2u){pk2(y.x, y.y), pk2(y.z, y.w)};
    LDS_WAIT(); __syncthreads();
}
__device__ __forceinline__ void conv_sample_one(const PArgs& a, LAS float* st_, int lane, int wave, int sidx) {
    unsigned char* ws = A_WS; const bf16* GLU = (const bf16*)(ws + WS_GLU); const bf16* GB = (const bf16*)(ws + WS_GB); bf16* CB = (bf16*)(ws + WS_CB);
    const int ch = 2 * lane + 128 * wave;
    const float* cw = A_IN(I_CONVW) + ch; const float* st = A_IN(I_SCONV) + (size_t)sidx * 30 * DA + ch; float* no = A_OUT + O_CVS + (size_t)sidx * 30 * DA + ch;
    const size_t m = (size_t)MP + sidx;
    f32x2 acc = *(const f32x2*)(A_IN(I_CONVB) + ch);
    const unsigned av = *(const unsigned*)(GLU + m * 1024 + ch), gc = *(const unsigned*)(GB + m * DA + ch);
    const f32x2 g = *(const f32x2*)(A_IN(I_CLNG) + ch), bb = *(const f32x2*)(A_IN(I_CLNB) + ch), w30 = *(const f32x2*)(cw + (size_t)30 * DA);
#pragma unroll 1
    for (int hf = 0; hf < 2; ++hf) {
        f32x2 x[15], w[15];
#pragma unroll
        for (int i = 0; i < 15; ++i) { const int j = hf * 15 + i; x[i] = *(const f32x2*)(st + (size_t)j * DA); w[i] = *(const f32x2*)(cw + (size_t)j * DA); }
#pragma unroll
        for (int i = 0; i < 15; ++i) { const int j = hf * 15 + i; acc += w[i] * x[i]; if (j >= 1) *(f32x2*)(no + (size_t)(j - 1) * DA) = x[i]; }
    }
    const f32x2 u = {bflo(av), bfhi(av)};
    acc += w30 * u; *(f32x2*)(no + (size_t)29 * DA) = u;
    const float s1 = wave_sum(acc.x + acc.y), s2 = wave_sum(acc.x * acc.x + acc.y * acc.y);
    if (lane == 0) { st_[wave * 2] = s1; st_[wave * 2 + 1] = s2; }
    LDS_WAIT(); __syncthreads();
    float t1 = 0.f, t2 = 0.f;
#pragma unroll
    for (int w = 0; w < 8; ++w) { t1 += st_[w * 2]; t2 += st_[w * 2 + 1]; }
    const float mean = t1 * (1.0f / 1024.0f), rstd = 1.0f / sqrtf(fmaxf(t2 * (1.0f / 1024.0f) - mean * mean, 0.f) + LN_EPS);
    const f32x2 y = (acc - mean) * rstd * g + bb;
    *(unsigned*)(CB + m * OAS + ch) = pk2(silu2(y.x, bflo(gc)), silu2(y.y, bfhi(gc)));
    LDS_WAIT(); __syncthreads();
}
#if USE_CHUNKED
__device__ __forceinline__ void p3_phase(const PArgs& a, LAS unsigned char* lds, int tid, int lane, int wave, int li) {
    constexpr int NIT = NB * NH * (SEQ / 64); const unsigned char* ws = A_WS;
    ChunkIn cur, nxt; int it = blockIdx.x;
    if (tid < 128) ((LAS float*)(lds + 15 * CMAT * 2 + 256))[512 + tid] = A_IN(I_MU)[3072 + tid];
    {
        const bf16* PS = (const bf16*)(A_WS + WS_PS); float* o_ = A_OUT + O_SHP;
        for (int i = blockIdx.x * NTHR + tid; i < NB * (SHW / 4); i += gridDim.x * NTHR) { const int b_ = i / (SHW / 4), c_ = i - b_ * (SHW / 4); const v2u x = *(const v2u*)(PS + ((size_t)b_ * SEQ + SEQ - 1) * PSW + 4 * c_);
            *(f32x4*)(o_ + (size_t)b_ * SHW + 4 * c_) = (f32x4){bflo(x.x), bfhi(x.x), bflo(x.y), bfhi(x.y)}; } }
    LoraW lw;
    if (it < NIT) { chunk_in_load(cur, a, it, tid); lora_load(lw, a, it, tid); }
    for (; it < NIT; it += gridDim.x) {
        const int itn = it + gridDim.x < NIT ? it + gridDim.x : it;
        chunk_in_load(nxt, a, itn, tid);
        chunk_pre(a, lds, tid, lane, wave, it, cur, PROBE_DUP == 3 && li == 1, lw, itn);
        cur = nxt;
    }
    __syncthreads();
}
__device__ __forceinline__ void p4_phase(const PArgs& a, LAS unsigned char* lds, int tid, int lane, int wave, int li) {
    const int G = gridDim.x, bid = blockIdx.x, ns = G > 64 ? 64 : G;
    const int pm = (PROBE_DUP == 4 && li == 1) ? (PROBE_P3MODE == 5 ? 1 : PROBE_P3MODE) : 0;
    if (bid < ns && (pm == 0 || pm == 1)) for (int bh = bid; bh < NB * NH; bh += ns) chunk_chain(a, lds, tid, lane, wave, bh, PROBE_P3MODE == 5 && PROBE_DUP == 4 && li == 1);
    if (pm == 0 || pm == 2) {
        if (G == 256) { const int ob_ = bid - 64; int i0_ = 0, n_ = 0;
            if (bid < 64) n_ = 0; else if (ob_ < 64) { i0_ = ob_; n_ = 1; } else if (ob_ < 128) { i0_ = 64 + 2 * (ob_ - 64); n_ = 2; } else { i0_ = 192 + (ob_ - 128); n_ = 1; }
            for (int q = 0; q < n_; ++q) conv_prompt_item(a, lds, tid, lane, wave, i0_ + q);
        } else for (int it = bid; it < 256; it += G) conv_prompt_item(a, lds, tid, lane, wave, it); }
    if (bid < ns && G > 64) { if ((pm == 0 || pm == 3) && G == 256) { LDS_WAIT(); __syncthreads(); conv_sample_one(a, (LAS float*)(lds + 90112), lane, wave, bid); } return; }
    if (!(pm == 0 || pm == 3)) return;
    const int ob = G > 64 ? bid - 64 : bid, on = G > 64 ? G - 64 : G;
    const int gwv = ob * NWAVES + wave, NGW = on * NWAVES;
    if (G == 256) { if (ob >= 128) conv_sample_one(a, (LAS float*)(lds + 90112), lane, wave, 64 + (ob - 128)); }
    else for (int it = on - 1 - ob; it < MS / 2; it += on) conv_sample_wg(a, (LAS float*)(lds + 90112), lane, wave, it);
    for (int it = gwv; it < MS * NH; it += NGW) sample_wkv_item(a, (LAS float*)(lds + 65536) + wave * 640, lane, it);
    {
        const bf16* PS = (const bf16*)(A_WS + WS_PS); float* o_ = A_OUT + O_SHS;
        for (int i = gwv * 64 + lane; i < MS * (SHW / 4); i += NGW * 64) { const int s_ = i / (SHW / 4), c_ = i - s_ * (SHW / 4); const v2u x = *(const v2u*)(PS + (size_t)(MP + s_) * PSW + 4 * c_);
            *(f32x4*)(o_ + (size_t)s_ * SHW + 4 * c_) = (f32x4){bflo(x.x), bfhi(x.x), bflo(x.y), bfhi(x.y)}; } }
    LDS_WAIT(); __syncthreads();
    if (pm == 0 && !(LATE_IN_P1 && G == 256)) late_weights(a, lds, lane, wave, 1, gwv, NGW);
}
#else
__device__ __forceinline__ void p3_phase(const PArgs& a, LAS unsigned char* lds, int tid, int lane, int wave, int li) {
    for (int it = blockIdx.x; it < NB * NH * 4; it += gridDim.x) scan_prompt(a, lds, tid, lane, wave, it);
}
__device__ __forceinline__ void p4_phase(const PArgs& a, LAS unsigned char* lds, int tid, int lane, int wave, int li) {
    const int G = gridDim.x, bid = blockIdx.x;
    const int gwv = bid * NWAVES + wave, NGW = G * NWAVES;
    for (int it = gwv; it < MS * NH; it += NGW) sample_wkv_item(a, (LAS float*)(lds + 65536) + wave * 640, lane, it);
    for (int it = bid; it < 256; it += G) conv_prompt_item(a, lds, tid, lane, wave, it);
    for (int it = G - 1 - bid; it < MS / 2; it += G) conv_sample_wg(a, (LAS float*)(lds + 90112), lane, wave, it);
    LDS_WAIT(); __syncthreads();
    late_weights(a, lds, lane, wave, 1, gwv, NGW);
}
#endif
__device__ __forceinline__ void p5_phase(const PArgs& a, int tid, int lane, int wave) {
    const int G = gridDim.x, bid = blockIdx.x;
    { unsigned char* ws = A_WS; GAS v4u* z1 = (GAS v4u*)(ws + WS_OA + (size_t)MV * OAS * 2);
      for (int i = bid * NTHR + tid; i < 128 * OAS * 2 / 16; i += G * NTHR) z1[i] = (v4u){0u, 0u, 0u, 0u}; }
    for (int m = bid * NWAVES + wave; m < MP; m += G * NWAVES) oa_token(a, lane, m);
}

__device__ __forceinline__ void thin_part(f32x4 (&acc)[4], const bf16* A, int lda, const bf16* Bt, int ldb, LAS unsigned char* wl, int lane) {
    const int lr = lane >> 3, lc = lane & 7, fr = lane & 15, fq = lane >> 4;
    const bf16* ag = A + (size_t)lr * lda + 8 * lc; const bf16* bg = Bt + (size_t)lr * ldb + 8 * lc;
    v4u ra[4][4], rb[4][4];
#pragma unroll
    for (int r = 0; r < 4; ++r) {
#pragma unroll
        for (int i = 0; i < 4; ++i) { ra[r][i] = *(const v4u*)(ag + (size_t)8 * i * lda + 64 * r); rb[r][i] = *(const v4u*)(bg + (size_t)8 * i * ldb + 64 * r); } }
    LAS unsigned char* wa = wl + lr * 144 + 16 * lc; const LAS unsigned char* fa = wl + fr * 144 + 16 * fq;
#pragma unroll
    for (int r = 0; r < 4; ++r) {
#pragma unroll
        for (int i = 0; i < 4; ++i) { *(LAS v4u*)(wa + 8 * i * 144) = ra[r][i]; *(LAS v4u*)(wa + 4608 + 8 * i * 144) = rb[r][i]; }
#pragma unroll
        for (int ks = 0; ks < 2; ++ks) {
            const bf16x8 a0 = *(const LAS bf16x8*)(fa + 64 * ks), a1 = *(const LAS bf16x8*)(fa + 16 * 144 + 64 * ks), b0 = *(const LAS bf16x8*)(fa + 4608 + 64 * ks), b1 = *(const LAS bf16x8*)(fa + 4608 + 16 * 144 + 64 * ks);
            acc[0] = __builtin_amdgcn_mfma_f32_16x16x32_bf16(a0, b0, acc[0], 0, 0, 0); acc[1] = __builtin_amdgcn_mfma_f32_16x16x32_bf16(a0, b1, acc[1], 0, 0, 0);
            acc[2] = __builtin_amdgcn_mfma_f32_16x16x32_bf16(a1, b0, acc[2], 0, 0, 0); acc[3] = __builtin_amdgcn_mfma_f32_16x16x32_bf16(a1, b1, acc[3], 0, 0, 0); }
    }
}
#define THIN_PUT(acc_) do { _Pragma("unroll") for (int tl_ = 0; tl_ < 4; ++tl_) xch[(wave * 4 + tl_) * 64 + lane] = acc_[tl_]; } while (0)
#define THIN_ITEM() const int c0 = ((j & 7) * 8 + (j >> 5)) * 32, rowbase = MP + ((j >> 3) & 3) * 32
#define THIN_MC() const size_t m = (size_t)rowbase + 16 * (wave >> 1) + 4 * fq + reg; const int col = c0 + 16 * (wave & 1) + fr
__device__ __forceinline__ void thin_g2(const PArgs& a, LAS unsigned char* lds, int lane, int wave) {
    unsigned char* ws = A_WS; const bf16* OA = (const bf16*)(ws + WS_OA); const bf16* WaT = (const bf16*)(ws + WS_WAT);
    const bf16* MG = (const bf16*)(ws + WS_MG); bf16* Mb = (bf16*)(ws + WS_MB);
    LAS f32x4* xch = (LAS f32x4*)(lds + 8 * 9216); const int fr = lane & 15, fq = lane >> 4;
    const f32x4 Z4 = {0.f, 0.f, 0.f, 0.f};
    for (int j = blockIdx.x; j < 256; j += gridDim.x) {
        THIN_ITEM();
        f32x4 acc[4] = {Z4, Z4, Z4, Z4};
        thin_part(acc, OA + (size_t)rowbase * OAS + 256 * wave, OAS, WaT + (size_t)c0 * OAS + 256 * wave, OAS, lds + wave * 9216, lane);
        THIN_PUT(acc);
        LDS_WAIT(); __syncthreads();
        if (wave < 4) { f32x4 ya = Z4, yb = Z4;
#pragma unroll
            for (int w = 0; w < 4; ++w) { ya += xch[(w * 4 + wave) * 64 + lane]; yb += xch[((w + 4) * 4 + wave) * 64 + lane]; }
#pragma unroll
            for (int reg = 0; reg < 4; ++reg) { THIN_MC();
                const float ga = bf1(MG[m * 4096 + col]), gb = bf1(MG[m * 4096 + 2048 + col]);
                Mb[m * DM + col] = (bf16)f2bf(sigm(ga) * ya[reg] + sigm(gb) * yb[reg]); } }
        LDS_WAIT(); __syncthreads();
    }
}
__device__ __forceinline__ void thin_g3(const PArgs& a, LAS unsigned char* lds, int lane, int wave) {
    unsigned char* ws = A_WS; const bf16* Mb = (const bf16*)(ws + WS_MB); const bf16* WoT = (const bf16*)(ws + WS_WOT); bf16* HB = (bf16*)(ws + WS_HB); const float* xs = A_IN(I_XS);
    LAS f32x4* xch = (LAS f32x4*)(lds + 8 * 9216); const int fr = lane & 15, fq = lane >> 4;
    const f32x4 Z4 = {0.f, 0.f, 0.f, 0.f};
    for (int j = blockIdx.x; j < 256; j += gridDim.x) {
        THIN_ITEM();
        f32x4 acc[4] = {Z4, Z4, Z4, Z4};
        thin_part(acc, Mb + (size_t)rowbase * DM + 256 * wave, DM, WoT + (size_t)c0 * DM + 256 * wave, DM, lds + wave * 9216, lane);
        THIN_PUT(acc);
        LDS_WAIT(); __syncthreads();
        if (wave < 4) { f32x4 y = Z4;
#pragma unroll
            for (int w = 0; w < 8; ++w) y += xch[(w * 4 + wave) * 64 + lane];
#pragma unroll
            for (int reg = 0; reg < 4; ++reg) { THIN_MC();
                HB[m * DM + col] = (bf16)f2bf(xs[(m - MP) * DM + col] + y[reg]); } }
        LDS_WAIT(); __syncthreads();
    }
}
__device__ __forceinline__ void thin_g4(const PArgs& a, LAS unsigned char* lds, int lane, int wave) {
    unsigned char* ws = A_WS; const bf16* HB = (const bf16*)(ws + WS_HB); const bf16* WgT = (const bf16*)(ws + WS_WGT); const bf16* PB = (const bf16*)(ws + WS_PB); const bf16* WpT = (const bf16*)(ws + WS_WPT); bf16* H2B = (bf16*)(ws + WS_H2B);
    LAS f32x4* xch = (LAS f32x4*)(lds + 8 * 9216); LAS f32x4* xch2 = xch + 8 * 4 * 64; const int fr = lane & 15, fq = lane >> 4;
    const f32x4 Z4 = {0.f, 0.f, 0.f, 0.f};
    for (int j = blockIdx.x; j < 256; j += gridDim.x) {
        THIN_ITEM();
        f32x4 acc[4] = {Z4, Z4, Z4, Z4}, ae[4];
        { const bf16* pa = PB + (size_t)(rowbase + fr) * PLE + 32 * wave + 8 * fq; const bf16* pb = WpT + (size_t)(c0 + fr) * PLE + 32 * wave + 8 * fq;
          const bf16x8 a0 = *(const bf16x8*)pa, a1 = *(const bf16x8*)(pa + 16 * PLE), b0 = *(const bf16x8*)pb, b1 = *(const bf16x8*)(pb + 16 * PLE);
          ae[0] = __builtin_amdgcn_mfma_f32_16x16x32_bf16(a0, b0, Z4, 0, 0, 0); ae[1] = __builtin_amdgcn_mfma_f32_16x16x32_bf16(a0, b1, Z4, 0, 0, 0);
          ae[2] = __builtin_amdgcn_mfma_f32_16x16x32_bf16(a1, b0, Z4, 0, 0, 0); ae[3] = __builtin_amdgcn_mfma_f32_16x16x32_bf16(a1, b1, Z4, 0, 0, 0); }
        thin_part(acc, HB + (size_t)rowbase * DM + 256 * wave, DM, WgT + (size_t)c0 * DM + 256 * wave, DM, lds + wave * 9216, lane);
        THIN_PUT(acc);
#pragma unroll
        for (int tl = 0; tl < 4; ++tl) xch2[(wave * 4 + tl) * 64 + lane] = ae[tl];
        LDS_WAIT(); __syncthreads();
        if (wave < 4) { f32x4 y = Z4, e = Z4;
#pragma unroll
            for (int w = 0; w < 8; ++w) { y += xch[(w * 4 + wave) * 64 + lane]; e += xch2[(w * 4 + wave) * 64 + lane]; }
#pragma unroll
            for (int reg = 0; reg < 4; ++reg) { THIN_MC();
                H2B[m * DM + col] = (bf16)f2bf(bf1(HB[m * DM + col]) + sigm(y[reg]) * e[reg]); } }
        LDS_WAIT(); __syncthreads();
    }
}
#undef THIN_PUT
#undef THIN_ITEM
#undef THIN_MC

__device__ __forceinline__ void final_norm(const PArgs& a, int lane, int wave, int vcu, int G, int mbeg = 0) {
    const int gw = vcu * NWAVES + wave, NGW = G * NWAVES; const float* fg = A_IN(I_FING); const bf16* H2B = (const bf16*)(A_WS + WS_H2B); float* out = A_OUT;
    for (int m = mbeg + gw; m < MV; m += NGW) {
        const GAS v4u* hr = (const GAS v4u*)(H2B + (size_t)m * DM) + lane;
        f32x4 v[8]; float s = 0.f;
#pragma unroll
        for (int j = 0; j < 4; ++j) { const v4u h = hr[64 * j];
            v[2 * j] = (f32x4){bflo(h.x), bfhi(h.x), bflo(h.y), bfhi(h.y)}; v[2 * j + 1] = (f32x4){bflo(h.z), bfhi(h.z), bflo(h.w), bfhi(h.w)};
            s += (v[2 * j].x * v[2 * j].x + v[2 * j].y * v[2 * j].y) + (v[2 * j].z * v[2 * j].z + v[2 * j].w * v[2 * j].w) + (v[2 * j + 1].x * v[2 * j + 1].x + v[2 * j + 1].y * v[2 * j + 1].y) + (v[2 * j + 1].z * v[2 * j + 1].z + v[2 * j + 1].w * v[2 * j + 1].w); }
        const float rs = 1.0f / sqrtf(wave_sum(s) * (1.0f / DM) + RMS_EPS);
        GAS f32x4* orow = (GAS f32x4*)(out + (size_t)m * DM);
#pragma unroll
        for (int j = 0; j < 4; ++j) { const int c4 = 2 * (lane + 64 * j);
            orow[c4] = v[2 * j] * rs * ((const GAS f32x4*)fg)[c4]; orow[c4 + 1] = v[2 * j + 1] * rs * ((const GAS f32x4*)fg)[c4 + 1]; }
    }
}

namespace pg8 {
struct EpiPleNorm {
    static constexpr bool PERM = true, AFTER_DRAIN = true, HAS_MID = false;
    const bf16_t* HB; const bf16_t* E; float* rowsq; const float* fg; float* out; XcdBarrier bar;
    __device__ __forceinline__ void fused(f32x4 (&acc)[2][2][4][2], const Unit& u, int wr, int wc, int, int, LAS unsigned char* lds, int, int) const {
        int t = threadIdx.x; asm volatile("" : "+v"(t)); const int lane = t & 63, fr = lane & 15, fq = lane >> 4;
        int row0 = u.pm * BM + wr * 64 + fr; const int col0 = u.pn * BM + wc * 32 + 8 * fq;
        asm volatile("" : "+v"(row0));
        LAS float* rs_l = (LAS float*)lds;
#pragma unroll
        for (int ai = 0; ai < 2; ++ai)
#pragma unroll
            for (int m = 0; m < 4; ++m) { const size_t row = (size_t)(row0 + ai * HALF + m * 16); float ss = 0.f;
#pragma unroll
                for (int bj = 0; bj < 2; ++bj) { const int col = col0 + bj * HALF; const u32x4 e = *(const u32x4*)(E + row * 2048 + col), h = *(const u32x4*)(HB + row * 2048 + col);
                    const f32x4 v0 = acc[ai][bj][m][0], v1 = acc[ai][bj][m][1];
                    f32x4 h0, h1;
                    h0[0] = bflo(h.x) + sigm(v0[0]) * bflo(e.x); h0[1] = bfhi(h.x) + sigm(v0[1]) * bfhi(e.x); h0[2] = bflo(h.y) + sigm(v0[2]) * bflo(e.y); h0[3] = bfhi(h.y) + sigm(v0[3]) * bfhi(e.y);
                    h1[0] = bflo(h.z) + sigm(v1[0]) * bflo(e.z); h1[1] = bfhi(h.z) + sigm(v1[1]) * bfhi(e.z); h1[2] = bflo(h.w) + sigm(v1[2]) * bflo(e.w); h1[3] = bfhi(h.w) + sigm(v1[3]) * bfhi(e.w);
                    acc[ai][bj][m][0] = h0; acc[ai][bj][m][1] = h1;
                    ss += ((h0[0] * h0[0] + h0[1] * h0[1]) + (h0[2] * h0[2] + h0[3] * h0[3])) + ((h1[0] * h1[0] + h1[1] * h1[1]) + (h1[2] * h1[2] + h1[3] * h1[3])); }
                ss += __shfl_xor(ss, 16); ss += __shfl_xor(ss, 32);
                if (fq == 0) rs_l[wc * 256 + wr * 64 + ai * HALF + m * 16 + fr] = ss;
                asm volatile("" ::: "memory"); }
        LDS_WAIT(); __syncthreads();
        if (t < 256) (void)__hip_atomic_fetch_add(rowsq + u.pm * BM + t, (rs_l[t] + rs_l[256 + t]) + (rs_l[512 + t] + rs_l[768 + t]), __ATOMIC_RELAXED, __HIP_MEMORY_SCOPE_AGENT);
        xcd_barrier(bar);
#pragma unroll
        for (int ai = 0; ai < 2; ++ai)
#pragma unroll
            for (int m = 0; m < 4; ++m) { const size_t row = (size_t)(row0 + ai * HALF + m * 16);
                const float rs = __builtin_amdgcn_rsqf(rowsq[row] * (1.0f / 2048.0f) + 1e-6f);
#pragma unroll
                for (int bj = 0; bj < 2; ++bj) { const int col = col0 + bj * HALF; const f32x4 g0 = *(const f32x4*)(fg + col), g1 = *(const f32x4*)(fg + col + 4);
                    __builtin_nontemporal_store(acc[ai][bj][m][0] * rs * g0, (f32x4*)(out + row * 2048 + col)); __builtin_nontemporal_store(acc[ai][bj][m][1] * rs * g1, (f32x4*)(out + row * 2048 + col + 4)); }
                asm volatile("" ::: "memory"); }
    }
};
}

__global__ void __launch_bounds__(NTHR, 2) hybrid_fwd(Args args) {
    extern __shared__ __attribute__((aligned(16))) unsigned char lds_raw[];
    LAS unsigned char* lds = (LAS unsigned char*)lds_raw;
    volatile LAS unsigned* MISC = (volatile LAS unsigned*)(lds + MISC_OFF);
    const int G = gridDim.x; const int bx = blockIdx.x; const int vcu = (G % 8 == 0) ? (bx % 8) * (G / 8) + bx / 8 : bx;
    {
        const int tid0 = opaque_tid();
        for (int u = tid0; u < (LDS_BYTES - LDSCTL_OFF) / 4; u += NTHR) ((LAS unsigned*)(lds + LDSCTL_OFF))[u] = 0u;
        __syncthreads();
        if (tid0 < 31) { const unsigned long long p = tid0 < 29 ? (unsigned long long)args.in[tid0] : (tid0 == 29 ? (unsigned long long)args.out : (unsigned long long)args.ws);
            *(LAS v2u*)(lds + LDSCTL_OFF + 8 * tid0) = (v2u){(unsigned)p, (unsigned)(p >> 32)}; }
        LDS_WAIT(); __syncthreads();
    }
    const PArgs a{lds};
    XcdBarrier bar; bar.bar = nullptr; bar.x = 0; bar.st = nullptr;
    if (N_LAUNCHES != PER_PHASE) bar = xcd_barrier_post((unsigned*)(A_WS + WS_CTL) + CW_BAR + args.li * XCD_BAR_WORDS, MISC + 8);
    const int lo = args.ph_lo, hi = args.ph_hi;
#define IN(k) (lo <= (k) && (k) < hi)
#define SEAM(k) do { if (IN(k) && IN((k) + 1)) xcd_barrier(bar); } while (0)
    using namespace pg8;
    if (IN(0)) { const int t = opaque_tid(); p0_prologue(a, lds, t & 63, __builtin_amdgcn_readfirstlane(t >> 6), vcu, G); SEAM(0); }
    if (IN(1)) {
        unsigned char* ws = A_WS;
        Gemm g{(const bf16_t*)(ws + WS_XN), (const bf16_t*)(ws + WS_WTIN), MPAD, N1, DM}; StaticOrder S; S.init(MPAD, N1, G, bx);
        EpiProj E{(bf16_t*)(ws + WS_PS), (bf16_t*)(ws + WS_GA), (bf16_t*)(ws + WS_GLU), (bf16_t*)(ws + WS_GB), (bf16_t*)(ws + WS_MG)};
        gemm_phase<EpiProj, StaticOrder, true, true>(lds, g, S, E);
        {
            const int nun = (MPAD / 256) * (N1 / 256), full = nun % G;
            if (full != 0 && bx >= full) { __syncthreads(); const int t = opaque_tid(); late_weights(a, lds, t & 63, __builtin_amdgcn_readfirstlane(t >> 6), 0, (bx - full) * NWAVES + (t >> 6), (G - full) * NWAVES);
                if (LATE_IN_P1) late_weights(a, lds, t & 63, __builtin_amdgcn_readfirstlane(t >> 6), 1, (bx - full) * NWAVES + (t >> 6), (G - full) * NWAVES); }
            else if (full == 0) { __syncthreads(); const int t = opaque_tid(); late_weights(a, lds, t & 63, __builtin_amdgcn_readfirstlane(t >> 6), 0, bx * NWAVES + (t >> 6), G * NWAVES); }
        }
        SEAM(1);
    }
    if (IN(3)) { const int t = opaque_tid(); p3_phase(a, lds, t, t & 63, __builtin_amdgcn_readfirstlane(t >> 6), args.li); SEAM(3); }
    if (IN(4)) { const int t = opaque_tid(); p4_phase(a, lds, t, t & 63, __builtin_amdgcn_readfirstlane(t >> 6), args.li); SEAM(4); }
    if (IN(5)) { const int t = opaque_tid(); p5_phase(a, t, t & 63, __builtin_amdgcn_readfirstlane(t >> 6)); SEAM(5); }
    if (IN(6)) {
        unsigned char* ws = A_WS;
        StaticOrder S; S.init(MP, DM, G, bx); S.wgm = 4;
        { Gemm g{(const bf16_t*)(ws + WS_OA), (const bf16_t*)(ws + WS_WAT), MP, DM, 2 * DA}; EpiGate E{(const bf16_t*)(ws + WS_MG), (bf16_t*)(ws + WS_MB)};
          gemm_phase<EpiGate, StaticOrder, true, true>(lds, g, S, E); }
        __syncthreads();
        { const int t = opaque_tid(); thin_g2(a, lds, t & 63, __builtin_amdgcn_readfirstlane(t >> 6)); }
        SEAM(6);
    }
    if (IN(7)) {
        unsigned char* ws = A_WS;
        { StaticOrder S; S.init(MP, DM, G, bx); S.wgm = 4; Gemm g{(const bf16_t*)(ws + WS_MB), (const bf16_t*)(ws + WS_WOT), MP, DM, DM};
          EpiRes E{A_IN(I_XP), A_IN(I_XS), (bf16_t*)(ws + WS_HB)};
          gemm_phase<EpiRes, StaticOrder, true, true>(lds, g, S, E); }
        __syncthreads();
        { StaticOrder S; S.init(MP, DM, G, G - 1 - bx); Gemm g{(const bf16_t*)(ws + WS_PB), (const bf16_t*)(ws + WS_WPT), MP, DM, PLE};
          EpiStoreBf16 E{(bf16_t*)(ws + WS_E), DM};
          gemm_phase<EpiStoreBf16, StaticOrder, true, true>(lds, g, S, E); }
        __syncthreads();
        { const int t = opaque_tid(); thin_g3(a, lds, t & 63, __builtin_amdgcn_readfirstlane(t >> 6)); }
        SEAM(7);
    }
    if (IN(8)) {
        unsigned char* ws = A_WS;
        StaticOrder S; S.init(MP, DM, G, bx); S.wgm = 4; Gemm g{(const bf16_t*)(ws + WS_HB), (const bf16_t*)(ws + WS_WGT), MP, DM, DM};
        if (FUSE_NORM && G == 256 && IN(9)) {
            { const int t = opaque_tid(); thin_g4(a, lds, t & 63, __builtin_amdgcn_readfirstlane(t >> 6)); }
            __syncthreads();
            EpiPleNorm E{(const bf16_t*)(ws + WS_HB), (const bf16_t*)(ws + WS_E), (float*)(ws + WS_CTL) + CW_ROWSQ, A_IN(I_FING), A_OUT, bar};
            gemm_phase<EpiPleNorm, StaticOrder, true, true>(lds, g, S, E);
            { const int t = opaque_tid(); final_norm(a, t & 63, __builtin_amdgcn_readfirstlane(t >> 6), vcu, G, MP); }
        } else {
            EpiPle E{(const bf16_t*)(ws + WS_HB), (const bf16_t*)(ws + WS_E), (bf16_t*)(ws + WS_H2B)};
            gemm_phase<EpiPle, StaticOrder, true, true>(lds, g, S, E);
            __syncthreads();
            { const int t = opaque_tid(); thin_g4(a, lds, t & 63, __builtin_amdgcn_readfirstlane(t >> 6)); }
            SEAM(8);
        }
    }
    if (IN(9) && !(FUSE_NORM && G == 256 && IN(8))) { const int t = opaque_tid(); final_norm(a, t & 63, __builtin_amdgcn_readfirstlane(t >> 6), vcu, G); }
#undef IN
#undef SEAM
}

extern "C" void kernel_launch(void* const* d_in, const int* in_sizes, int n_in, void* d_out, int out_size, void* d_ws, size_t ws_size, hipStream_t stream) {
    static int grid = 0;
    if (grid == 0) {
        if (n_in != 29 || out_size != (int)O_END || ws_size < WS_END) { fprintf(stderr, "kernel_launch: built for 29 inputs, %zu outputs, >= %zu bytes of workspace; got n_in %d, out %d, ws %zu; nothing launched\n", (size_t)O_END, (size_t)WS_END, n_in, out_size, ws_size); grid = -1; return; }
        int dev = 0, cus = 0, per_cu = 0;
        if (hipGetDevice(&dev) != hipSuccess || hipDeviceGetAttribute(&cus, hipDeviceAttributeMultiprocessorCount, dev) != hipSuccess) { fprintf(stderr, "kernel_launch: device query failed\n"); grid = -1; return; }
        if (hipFuncSetAttribute((const void*)hybrid_fwd, hipFuncAttributeMaxDynamicSharedMemorySize, LDS_BYTES) != hipSuccess) { fprintf(stderr, "kernel_launch: hipFuncSetAttribute failed\n"); grid = -1; return; }
        if (hipOccupancyMaxActiveBlocksPerMultiprocessor(&per_cu, (const void*)hybrid_fwd, NTHR, LDS_BYTES) != hipSuccess || per_cu < 1)
            fprintf(stderr, "kernel_launch: note: occupancy query reports %d workgroups per CU\n", per_cu);
        (void)hipGetLastError();
        grid = cus;
    }
    if (grid < 0) return;
    if (hipMemsetAsync((char*)d_ws + WS_CTL, 0, CTL_ZERO_BYTES, stream) != hipSuccess) { fprintf(stderr, "kernel_launch: hipMemsetAsync failed\n"); return; }
    Args a{};
    for (int i = 0; i < 29; ++i) a.in[i] = (const float*)d_in[i];
    a.out = (float*)d_out; a.ws = (unsigned char*)d_ws;
    const int nl = (PROBE_DUP >= 0) ? 2 : N_LAUNCHES;
    for (int li = 0; li < nl; ++li) {
        a.ph_lo = (N_LAUNCHES == PER_PHASE) ? li : 0; a.ph_hi = (N_LAUNCHES == PER_PHASE) ? li + 1 : PER_PHASE; a.li = li;
        if (PROBE_DUP >= 0) { a.ph_lo = li == 0 ? 0 : (PROBE_DUP == 8 ? 7 : PROBE_DUP); a.ph_hi = li == 0 ? PROBE_DUP + 1 : PER_PHASE; }
        hipLaunchKernelGGL(hybrid_fwd, dim3(grid), dim3(NTHR), LDS_BYTES, stream, a);
        const hipError_t le = hipPeekAtLastError();
        if (le != hipSuccess) { fprintf(stderr, "kernel_launch: launch %d failed: %s\n", li, hipGetErrorName(le)); break; }
    }
}
```
